# Optimizing an MI355X kernel written in HIP

```python
import numpy as np
import jax, jax.numpy as jnp
from jax import lax

D_MODEL = 1024
BATCH = 8
SEQ = 4096
DEPTH = 4

ROPE_THETA = 500000.0
NORM_EPS = 1e-6
Q_BLOCK = 128
MLA_HEADS = 8
MLA_NOPE_DIM = 64
MLA_ROPE_DIM = 32
MLA_QK_DIM = MLA_NOPE_DIM + MLA_ROPE_DIM
MLA_V_DIM = 64
MLA_Q_RANK = 384
MLA_KV_RANK = 256
CONV_CH = 512
CONV_WIDTH = 31
NSA_HEADS = 8
NSA_KV_GROUPS = 2
NSA_HEAD_DIM = 64
NSA_ROPE_DIM = NSA_HEAD_DIM // 4
NSA_N_BRANCH = 3
CMP_BLOCK = 32
CMP_STRIDE = 16
CMP_HIDDEN = 128
SLC_BLOCK = 64
SLC_TOP_N = 16
WINDOW = 512
NSA_Q_BLOCK = 64
FORCED_BLOCK_SCORE = 1e6
N_MIXERS = 3
D_FF = 4 * D_MODEL

IN_SPLITS = (
    MLA_Q_RANK,
    MLA_KV_RANK,
    MLA_ROPE_DIM,
    2 * CONV_CH,
    NSA_HEADS * NSA_HEAD_DIM,
    2 * NSA_N_BRANCH * NSA_KV_GROUPS * NSA_HEAD_DIM,
    NSA_N_BRANCH * NSA_HEADS,
    N_MIXERS * D_MODEL,
)
D_IN = sum(IN_SPLITS)
SPLIT_IDX = tuple(int(v) for v in np.cumsum(IN_SPLITS)[:-1])

kernel_name = "hybrid_mla_conformer_nsa_block"


def rms_norm(x, g):
    xf = x.astype(jnp.float32)
    y = xf * lax.rsqrt(jnp.mean(xf * xf, axis=-1, keepdims=True) + NORM_EPS)
    return (y * g.astype(jnp.float32)).astype(x.dtype)


def layer_norm(x, g, b):
    xf = x.astype(jnp.float32)
    mu = jnp.mean(xf, axis=-1, keepdims=True)
    var = jnp.mean(jnp.square(xf - mu), axis=-1, keepdims=True)
    y = (xf - mu) * lax.rsqrt(var + NORM_EPS)
    return (y * g.astype(jnp.float32) + b.astype(jnp.float32)).astype(x.dtype)


def rope(x, pos, rot_dim):
    half = rot_dim // 2
    inv = jnp.power(jnp.float32(ROPE_THETA), -jnp.arange(half, dtype=jnp.float32) * (2.0 / rot_dim))
    ang = pos.astype(jnp.float32)[:, None] * inv
    cos = jnp.cos(ang)[:, None, :]
    sin = jnp.sin(ang)[:, None, :]
    xf = x.astype(jnp.float32)
    x1, x2 = xf[..., :half], xf[..., half:rot_dim]
    out = jnp.concatenate([x1 * cos - x2 * sin, x2 * cos + x1 * sin, xf[..., rot_dim:]], axis=-1)
    return out.astype(x.dtype)


def masked_softmax(s, mask):
    s = jnp.where(mask, s.astype(jnp.float32), -jnp.inf)
    m = jnp.max(s, axis=-1, keepdims=True)
    m = jnp.where(jnp.isfinite(m), m, 0.0)
    p = jnp.exp(s - m)
    return p / jnp.maximum(jnp.sum(p, axis=-1, keepdims=True), 1e-30)


def mla_mixer(c_q, c_kv, k_rope, g_cq, g_ckv, w_uq, w_ukv, g_q, g_k, w_o, pos):
    B, S, _ = c_q.shape
    dt = c_q.dtype
    q = (rms_norm(c_q, g_cq) @ w_uq).reshape(B, S, MLA_HEADS, MLA_QK_DIM)
    kv = (rms_norm(c_kv, g_ckv) @ w_ukv).reshape(B, S, MLA_HEADS, MLA_NOPE_DIM + MLA_V_DIM)
    k_nope, v = kv[..., :MLA_NOPE_DIM], kv[..., MLA_NOPE_DIM:]
    k_r = jnp.broadcast_to(k_rope[:, :, None, :], (B, S, MLA_HEADS, MLA_ROPE_DIM))
    k = jnp.concatenate([k_r, k_nope], axis=-1)
    q = rope(rms_norm(q, g_q), pos, MLA_ROPE_DIM)
    k = rope(rms_norm(k, g_k), pos, MLA_ROPE_DIM)
    scale = MLA_QK_DIM ** -0.5

    def block(i):
        qb = lax.dynamic_slice_in_dim(q, i * Q_BLOCK, Q_BLOCK, axis=1)
        t = i * Q_BLOCK + jnp.arange(Q_BLOCK)
        s = jnp.einsum('bqhd,bkhd->bhqk', qb, k) * scale
        p = masked_softmax(s, pos[None, :] <= t[:, None])
        return jnp.einsum('bhqk,bkhd->bqhd', p.astype(dt), v)

    o = lax.map(block, jnp.arange(S // Q_BLOCK))
    o = jnp.moveaxis(o, 0, 1).reshape(B, S, MLA_HEADS * MLA_V_DIM)
    return o @ w_o


def conv_mixer(u2, b_glu, w_dw, b_dw, g_ln, b_ln, w_out, b_out):
    a, gate = jnp.split(u2 + b_glu, 2, axis=-1)
    u = a * jax.nn.sigmoid(gate)
    u = lax.conv_general_dilated(u, w_dw[:, None, :], (1,), [(CONV_WIDTH - 1, 0)],
                                 dimension_numbers=('NWC', 'WIO', 'NWC'),
                                 feature_group_count=CONV_CH) + b_dw
    u = jax.nn.silu(layer_norm(u, g_ln, b_ln))
    return u @ w_out + b_out


def compress(tok, pe, w1, w2):
    B, S, G, dh = tok.shape
    n_cmp = (S - CMP_BLOCK) // CMP_STRIDE + 1
    idx = (jnp.arange(n_cmp) * CMP_STRIDE)[:, None] + jnp.arange(CMP_BLOCK)[None, :]
    blocks = tok[:, idx] + pe[None, None, :, None, :]
    blocks = jnp.moveaxis(blocks, 2, 3).reshape(B, n_cmp, G, CMP_BLOCK * dh)
    return jax.nn.silu(blocks @ w1) @ w2


def nsa_mixer(q_raw, kv_raw, gate_logits, pe_k, pe_v, w_ck1, w_ck2, w_cv1, w_cv2, g_q, g_k, w_o, pos):
    B, S, _ = q_raw.shape
    dt = q_raw.dtype
    H, G, dh = NSA_HEADS, NSA_KV_GROUPS, NSA_HEAD_DIM
    hpg = H // G
    QB = NSA_Q_BLOCK
    q = rope(rms_norm(q_raw.reshape(B, S, H, dh), g_q), pos, NSA_ROPE_DIM)
    kv = kv_raw.reshape(B, S, 2 * NSA_N_BRANCH, G, dh)
    kc, vc, ks, vs, kw, vw = [kv[:, :, j] for j in range(2 * NSA_N_BRANCH)]
    n_cmp = (S - CMP_BLOCK) // CMP_STRIDE + 1
    cmp_pos = jnp.arange(n_cmp) * CMP_STRIDE + CMP_BLOCK - 1
    k_cmp = rope(rms_norm(compress(kc, pe_k, w_ck1, w_ck2), g_k), cmp_pos, NSA_ROPE_DIM)
    v_cmp = compress(vc, pe_v, w_cv1, w_cv2)
    n_slc = S // SLC_BLOCK
    top_n = min(SLC_TOP_N, n_slc)
    k_slc = rope(rms_norm(ks, g_k), pos, NSA_ROPE_DIM)
    k_slc_blk = k_slc.reshape(B, n_slc, SLC_BLOCK, G, dh).transpose(0, 3, 1, 2, 4)
    v_slc_blk = vs.reshape(B, n_slc, SLC_BLOCK, G, dh).transpose(0, 3, 1, 2, 4)
    c_start = jnp.arange(n_cmp) * CMP_STRIDE
    s_start = jnp.arange(n_slc) * SLC_BLOCK
    overlap = ((c_start[:, None] < s_start[None, :] + SLC_BLOCK)
               & (c_start[:, None] + CMP_BLOCK > s_start[None, :])).astype(jnp.float32)
    k_win = rope(rms_norm(kw, g_k), pos, NSA_ROPE_DIM)
    k_win_pad = jnp.pad(k_win, ((0, 0), (WINDOW, 0), (0, 0), (0, 0)))
    v_win_pad = jnp.pad(vw, ((0, 0), (WINDOW, 0), (0, 0), (0, 0)))
    scale = dh ** -0.5
    bi = jnp.arange(B)[:, None, None, None]
    gi = jnp.arange(G)[None, :, None, None]
    j_blk = jnp.arange(n_slc)

    def block(i):
        q0 = i * QB
        t = q0 + jnp.arange(QB)
        qb = lax.dynamic_slice_in_dim(q, q0, QB, axis=1).reshape(B, QB, G, hpg, dh)
        s_c = jnp.einsum('bqghd,bcgd->bghqc', qb, k_cmp) * scale
        p_c = masked_softmax(s_c, cmp_pos[None, :] <= t[:, None])
        o_c = jnp.einsum('bghqc,bcgd->bqghd', p_c.astype(dt), v_cmp)
        imp = jnp.einsum('bghqc,cn->bgqn', p_c, overlap)
        blk_t = t // SLC_BLOCK
        forced = ((j_blk[None, :] == 0) | (j_blk[None, :] == blk_t[:, None])
                  | (j_blk[None, :] == blk_t[:, None] - 1))
        imp = jnp.where(forced, FORCED_BLOCK_SCORE, imp)
        imp = jnp.where(j_blk[None, :] > blk_t[:, None], -jnp.inf, imp)
        _, idx = lax.top_k(imp, top_n)
        k_sel = k_slc_blk[bi, gi, idx]
        v_sel = v_slc_blk[bi, gi, idx]
        s_s = jnp.einsum('bqghd,bgqnkd->bghqnk', qb, k_sel) * scale
        kpos = idx[..., None] * SLC_BLOCK + jnp.arange(SLC_BLOCK)
        m_s = (kpos <= t[None, None, :, None, None])[:, :, None]
        p_s = masked_softmax(s_s.reshape(B, G, hpg, QB, top_n * SLC_BLOCK),
                             m_s.reshape(B, G, 1, QB, top_n * SLC_BLOCK))
        o_s = jnp.einsum('bghqnk,bgqnkd->bqghd', p_s.reshape(s_s.shape).astype(dt), v_sel)
        k_w = lax.dynamic_slice_in_dim(k_win_pad, q0, WINDOW + QB, axis=1)
        v_w = lax.dynamic_slice_in_dim(v_win_pad, q0, WINDOW + QB, axis=1)
        wpos = q0 - WINDOW + jnp.arange(WINDOW + QB)
        m_w = ((wpos[None, :] <= t[:, None]) & (wpos[None, :] > t[:, None] - WINDOW)
               & (wpos[None, :] >= 0))
        s_w = jnp.einsum('bqghd,bkgd->bghqk', qb, k_w) * scale
        p_w = masked_softmax(s_w, m_w)
        o_w = jnp.einsum('bghqk,bkgd->bqghd', p_w.astype(dt), v_w)
        return jnp.stack([o_c, o_s, o_w], axis=-2)

    o = lax.map(block, jnp.arange(S // QB))
    o = jnp.moveaxis(o, 0, 1).reshape(B, S, H, NSA_N_BRANCH, dh)
    g = jax.nn.sigmoid(gate_logits.reshape(B, S, H, NSA_N_BRANCH).astype(jnp.float32)).astype(dt)
    o = jnp.einsum('bshnd,bshn->bshd', o, g).reshape(B, S, H * dh)
    return o @ w_o


def hybrid_layer(x, pos, g_mix, w_in, g_cq, g_ckv, w_uq, w_ukv, g_q_mla, g_k_mla, w_o_mla,
                 b_glu, w_dw, b_dw, g_conv_ln, b_conv_ln, w_conv_out, b_conv_out,
                 pe_cmp_k, pe_cmp_v, w_cmp_k1, w_cmp_k2, w_cmp_v1, w_cmp_v2,
                 g_q_nsa, g_k_nsa, w_o_nsa, w_out, g_ffn, w_ff1, w_ff2):
    dt = x.dtype
    h = rms_norm(x, g_mix)
    z = h @ w_in
    c_q, c_kv, k_rope, u2, q_nsa, kv_nsa, gate_nsa, gate_mix = jnp.split(z, SPLIT_IDX, axis=-1)
    o_a = mla_mixer(c_q, c_kv, k_rope, g_cq, g_ckv, w_uq, w_ukv, g_q_mla, g_k_mla, w_o_mla, pos)
    o_b = conv_mixer(u2, b_glu, w_dw, b_dw, g_conv_ln, b_conv_ln, w_conv_out, b_conv_out)
    o_c = nsa_mixer(q_nsa, kv_nsa, gate_nsa, pe_cmp_k, pe_cmp_v, w_cmp_k1, w_cmp_k2,
                    w_cmp_v1, w_cmp_v2, g_q_nsa, g_k_nsa, w_o_nsa, pos)
    g_a, g_b, g_c = jnp.split(jax.nn.sigmoid(gate_mix.astype(jnp.float32)).astype(dt), N_MIXERS, axis=-1)
    x = x + (g_a * o_a + g_b * o_b + g_c * o_c) @ w_out
    h = rms_norm(x, g_ffn)
    x = x + jnp.square(jax.nn.relu(h @ w_ff1)) @ w_ff2
    return x


def setup_inputs(seed: int = 0) -> dict:
    key = jax.random.key(seed)
    ks = iter(jax.random.split(key, 40))
    L = DEPTH
    res = (2.0 * DEPTH) ** -0.5

    def nrm(shape, scale):
        return jax.random.normal(next(ks), shape, jnp.float32) * scale

    def gain(shape):
        return 1.0 + nrm(shape, 0.02)

    return {
        "x": nrm((BATCH, SEQ, D_MODEL), 1.0),
        "g_mix": gain((L, D_MODEL)),
        "w_in": nrm((L, D_MODEL, D_IN), D_MODEL ** -0.5),
        "g_cq": gain((L, MLA_Q_RANK)),
        "g_ckv": gain((L, MLA_KV_RANK)),
        "w_uq": nrm((L, MLA_Q_RANK, MLA_HEADS * MLA_QK_DIM), MLA_Q_RANK ** -0.5),
        "w_ukv": nrm((L, MLA_KV_RANK, MLA_HEADS * (MLA_NOPE_DIM + MLA_V_DIM)), MLA_KV_RANK ** -0.5),
        "g_q_mla": gain((L, MLA_QK_DIM)),
        "g_k_mla": gain((L, MLA_QK_DIM)),
        "w_o_mla": nrm((L, MLA_HEADS * MLA_V_DIM, D_MODEL), (MLA_HEADS * MLA_V_DIM) ** -0.5),
        "b_glu": nrm((L, 2 * CONV_CH), 0.01),
        "w_dw": nrm((L, CONV_WIDTH, CONV_CH), CONV_WIDTH ** -0.5),
        "b_dw": nrm((L, CONV_CH), 0.01),
        "g_conv_ln": gain((L, CONV_CH)),
        "b_conv_ln": nrm((L, CONV_CH), 0.01),
        "w_conv_out": nrm((L, CONV_CH, D_MODEL), CONV_CH ** -0.5),
        "b_conv_out": nrm((L, D_MODEL), 0.01),
        "pe_cmp_k": nrm((L, CMP_BLOCK, NSA_HEAD_DIM), 0.1),
        "pe_cmp_v": nrm((L, CMP_BLOCK, NSA_HEAD_DIM), 0.1),
        "w_cmp_k1": nrm((L, CMP_BLOCK * NSA_HEAD_DIM, CMP_HIDDEN), (CMP_BLOCK * NSA_HEAD_DIM) ** -0.5),
        "w_cmp_k2": nrm((L, CMP_HIDDEN, NSA_HEAD_DIM), CMP_HIDDEN ** -0.5),
        "w_cmp_v1": nrm((L, CMP_BLOCK * NSA_HEAD_DIM, CMP_HIDDEN), (CMP_BLOCK * NSA_HEAD_DIM) ** -0.5),
        "w_cmp_v2": nrm((L, CMP_HIDDEN, NSA_HEAD_DIM), CMP_HIDDEN ** -0.5),
        "g_q_nsa": gain((L, NSA_HEAD_DIM)),
        "g_k_nsa": gain((L, NSA_HEAD_DIM)),
        "w_o_nsa": nrm((L, NSA_HEADS * NSA_HEAD_DIM, D_MODEL), (NSA_HEADS * NSA_HEAD_DIM) ** -0.5),
        "w_out": nrm((L, D_MODEL, D_MODEL), D_MODEL ** -0.5 * res),
        "g_ffn": gain((L, D_MODEL)),
        "w_ff1": nrm((L, D_MODEL, D_FF), D_MODEL ** -0.5),
        "w_ff2": nrm((L, D_FF, D_MODEL), D_FF ** -0.5 * res),
    }


def reference(x, g_mix, w_in, g_cq, g_ckv, w_uq, w_ukv, g_q_mla, g_k_mla, w_o_mla,
              b_glu, w_dw, b_dw, g_conv_ln, b_conv_ln, w_conv_out, b_conv_out,
              pe_cmp_k, pe_cmp_v, w_cmp_k1, w_cmp_k2, w_cmp_v1, w_cmp_v2,
              g_q_nsa, g_k_nsa, w_o_nsa, w_out, g_ffn, w_ff1, w_ff2):
    pos = jnp.arange(x.shape[1])
    for l in range(DEPTH):
        x = hybrid_layer(x, pos, g_mix[l], w_in[l], g_cq[l], g_ckv[l], w_uq[l], w_ukv[l],
                         g_q_mla[l], g_k_mla[l], w_o_mla[l], b_glu[l], w_dw[l], b_dw[l],
                         g_conv_ln[l], b_conv_ln[l], w_conv_out[l], b_conv_out[l],
                         pe_cmp_k[l], pe_cmp_v[l], w_cmp_k1[l], w_cmp_k2[l], w_cmp_v1[l], w_cmp_v2[l],
                         g_q_nsa[l], g_k_nsa[l], w_o_nsa[l], w_out[l], g_ffn[l], w_ff1[l], w_ff2[l])
    return x
```

```cpp
#include <hip/hip_runtime.h>
#include <hip/hip_cooperative_groups.h>
#include <cstdio>
#include <cstdint>
namespace cg = cooperative_groups;

#define DI __device__ __forceinline__
#define LAS __attribute__((address_space(3)))
typedef unsigned short bf16;
typedef short bf16x8 __attribute__((ext_vector_type(8)));
typedef short s16x4 __attribute__((ext_vector_type(4)));
typedef float f32x4 __attribute__((ext_vector_type(4)));
typedef float f32x16 __attribute__((ext_vector_type(16)));
typedef unsigned u32x4 __attribute__((ext_vector_type(4)));
typedef unsigned u32x2 __attribute__((ext_vector_type(2)));
typedef float f32x2_t __attribute__((ext_vector_type(2)));
typedef __bf16 bf16x2_t __attribute__((ext_vector_type(2)));

DI unsigned pk2(float lo, float hi) { f32x2_t v = {lo, hi}; bf16x2_t b = __builtin_convertvector(v, bf16x2_t); return __builtin_bit_cast(unsigned, b); }
DI float bflo(unsigned w) { return __uint_as_float(w << 16); }
DI float bfhi(unsigned w) { return __uint_as_float(w & 0xffff0000u); }
DI float bf2f(bf16 b) { return __uint_as_float(((unsigned)b) << 16); }
DI bf16 f2bf(float f) { return (bf16)(pk2(f, 0.f) & 0xffffu); }
DI float wave_sum(float v) {
#pragma unroll
    for (int o = 1; o < 64; o <<= 1) v += __shfl_xor(v, o);
    return v;
}
DI float sigmoidf_(float x) { return 1.0f / (1.0f + __expf(-x)); }
DI void unpack8(const u32x4 w, float (&f)[8]) { f[0] = bflo(w.x); f[1] = bfhi(w.x); f[2] = bflo(w.y); f[3] = bfhi(w.y); f[4] = bflo(w.z); f[5] = bfhi(w.z); f[6] = bflo(w.w); f[7] = bfhi(w.w); }
DI u32x4 pack8(const float (&f)[8]) { u32x4 w; w.x = pk2(f[0], f[1]); w.y = pk2(f[2], f[3]); w.z = pk2(f[4], f[5]); w.w = pk2(f[6], f[7]); return w; }
DI void load8f(const float* p, float (&f)[8]) { const f32x4 a = *(const f32x4*)p, b = *(const f32x4*)(p + 4); f[0] = a[0]; f[1] = a[1]; f[2] = a[2]; f[3] = a[3]; f[4] = b[0]; f[5] = b[1]; f[6] = b[2]; f[7] = b[3]; }

namespace pg8 {
#define PG8_LAS __attribute__((address_space(3)))
typedef unsigned short bf16_t;
constexpr int BM = 256, BK = 64, HALF = 128, HTB = HALF * BK * 2, STAGE_BYTES = 8 * HTB, NXCD = 8, WGM = 8;

__host__ __device__ __forceinline__ int lds_byte(int r, int c) { const int st = (r >> 4) * 2 + (c >> 5), rr = r & 15, cc = c & 31, ob = rr * 64 + cc * 2; return st * 1024 + (ob ^ (((ob >> 9) & 1) << 5)); }
__host__ __device__ __forceinline__ void stage_rc(int b, int& R, int& C) { const int st = b / 1024, sb = b % 1024, swz = sb ^ (((sb >> 9) & 1) << 5); R = (st >> 1) * 16 + swz / 64; C = (st & 1) * 32 + (swz % 64) / 2; }
__host__ __device__ __forceinline__ int perm32(int rho) { const int n = rho >> 4, i = rho & 15; return 8 * (i >> 2) + 4 * n + (i & 3); }

struct Unit { int pm, pn; };
struct Gemm { const bf16_t* A; const bf16_t* Bt; int M, N, K, lda; };

struct StaticOrder {
    int nM, nN, nwg, G, c;
    __device__ void init(int M, int N, int G_, int c_) { nM = M / BM; nN = N / BM; nwg = nM * nN; G = G_; c = c_; }
    __device__ bool next(int i, Unit& u) const {
        const long L = (long)i * G + c; if (L >= nwg) return false;
        int wgid = (int)L; { const int q = nwg / NXCD, r = nwg % NXCD, xcd = wgid % NXCD, off = wgid / NXCD; wgid = (xcd < r ? xcd * (q + 1) : r * (q + 1) + (xcd - r) * q) + off; }
        const int nig = WGM * nN, gid = wgid / nig, fm = gid * WGM, gsz = (nM - fm) < WGM ? (nM - fm) : WGM;
        u.pm = fm + ((wgid % nig) % gsz); u.pn = (wgid % nig) / gsz; return true;
    }
};

struct TripleOrder {
    StaticOrder so;
    __device__ void init(int M, int G_, int c_) { so.init(M, 1024, G_, c_); }
    __device__ bool next(int i, Unit& u) const { Unit s; if (!so.next(i / 3, s)) return false; u.pm = s.pm; u.pn = (i % 3) * 4 + s.pn; return true; }
};

template <class F> struct EpiF {
    static constexpr bool PERM = true;
    F f;
    __device__ __forceinline__ void operator()(const f32x4 (&acc)[2][2][4][2], const Unit& u, int wr, int wc, int fr, int fq) const {
        const int row0 = u.pm * BM + wr * 64 + fr, col0 = u.pn * BM + wc * 32 + 8 * fq;
#pragma unroll
        for (int ai = 0; ai < 2; ++ai)
#pragma unroll
            for (int m = 0; m < 4; ++m) {
                const int row = row0 + ai * HALF + m * 16;
                const float rc = f.rowctx(row);
#pragma unroll
                for (int bj = 0; bj < 2; ++bj) f(row, col0 + bj * HALF, acc[ai][bj][m][0], acc[ai][bj][m][1], rc);
            }
    }
};

template <class Epi, class Sched>
__device__ __forceinline__ void gemm_phase(PG8_LAS unsigned char* lds, const Gemm g, const Sched& S, const Epi& E) {
    int tid_ = threadIdx.x; asm volatile("" : "+v"(tid_));
    const int tid = tid_, wid = __builtin_amdgcn_readfirstlane(tid >> 6), lane = tid & 63, wr = wid >> 2, wc = wid & 3, fr = lane & 15, fq = lane >> 4;
    int K_ = g.K, lda_ = g.lda; asm volatile("" : "+s"(K_), "+s"(lda_));
    const int K = K_, nt = K / BK, lda = lda_;
    unsigned voffA[2], voffB[2];
#pragma unroll
    for (int i = 0; i < 2; ++i) { int R, C; stage_rc(tid * 16 + i * 8192, R, C); const int Rb = Epi::PERM ? ((R & ~31) + perm32(R & 31)) : R;
        voffA[i] = (unsigned)(R * lda + C) * 2u; voffB[i] = (unsigned)(Rb * K + C) * 2u; }
    const size_t kstep = (size_t)(BK * 2);
    const size_t hstepA = (size_t)HALF * lda * 2, hstepB = (size_t)HALF * K * 2;
    const size_t tstepA = 2 * hstepA, tstepB = 2 * hstepB;
    const unsigned ldsw = (unsigned)wid * 1024u;
    const int aoff = lds_byte(wr * 64 + fr, fq * 8), boff = lds_byte(wc * 32 + fr, fq * 8);
#define PG8_SA(b, h) (((b) * 2 + (h)) * HTB)
#define PG8_SB(b, h) ((4 + (b) * 2 + (h)) * HTB)
#define PG8_STAGE(bufoff, gbase, voff) do { _Pragma("unroll") for (int _i = 0; _i < 2; ++_i) \
        __builtin_amdgcn_global_load_lds((const unsigned*)((const char*)(gbase) + (voff)[_i]), (PG8_LAS unsigned*)(lds + (bufoff) + ldsw + _i * 8192), 16, 0, 0); } while (0)
#define PG8_LDA(dst, b, h) do { _Pragma("unroll") for (int m = 0; m < 4; ++m) _Pragma("unroll") for (int k = 0; k < 2; ++k) dst[m][k] = *(const PG8_LAS bf16x8*)(lds + PG8_SA(b, h) + aoff + m * 2048 + k * 1024); } while (0)
#define PG8_LDB(dst, b, h) do { _Pragma("unroll") for (int n = 0; n < 2; ++n) _Pragma("unroll") for (int k = 0; k < 2; ++k) dst[n][k] = *(const PG8_LAS bf16x8*)(lds + PG8_SB(b, h) + boff + n * 2048 + k * 1024); } while (0)
#define PG8_MMA(ai, bj, At, Bt) do { __builtin_amdgcn_s_setprio(1); _Pragma("unroll") for (int m = 0; m < 4; ++m) _Pragma("unroll") for (int n = 0; n < 2; ++n) _Pragma("unroll") for (int k = 0; k < 2; ++k) \
        acc[ai][bj][m][n] = __builtin_amdgcn_mfma_f32_16x16x32_bf16(Bt[n][k], At[m][k], acc[ai][bj][m][n], 0, 0, 0); __builtin_amdgcn_s_setprio(0); } while (0)
#define PG8_WAIT_V(n) asm volatile("s_waitcnt vmcnt(" #n ")" ::: "memory")
#define PG8_WAIT_L(n) asm volatile("s_waitcnt lgkmcnt(" #n ")" ::: "memory")
#define PG8_BAR __builtin_amdgcn_s_barrier()
#define PG8_SCHED __builtin_amdgcn_sched_barrier(0)
    Unit cur, nxt; int ui = 0;
    if (!S.next(0, cur)) return;
    f32x4 acc[2][2][4][2];
#pragma unroll
    for (int a = 0; a < 2; ++a)
#pragma unroll
        for (int b = 0; b < 2; ++b)
#pragma unroll
            for (int m = 0; m < 4; ++m)
#pragma unroll
                for (int n = 0; n < 2; ++n) acc[a][b][m][n] = (f32x4){0.f, 0.f, 0.f, 0.f};
    bf16x8 At[4][2], B0[2][2], B1[2][2];
    const char* cA = (const char*)g.A + (size_t)cur.pm * tstepA; const char* cB = (const char*)g.Bt + (size_t)cur.pn * tstepB;
    PG8_STAGE(PG8_SB(0, 0), cB, voffB); PG8_STAGE(PG8_SB(0, 1), cB + hstepB, voffB); PG8_STAGE(PG8_SA(0, 0), cA, voffA); PG8_STAGE(PG8_SA(0, 1), cA + hstepA, voffA);
    if (wr == 1) PG8_BAR;
    PG8_WAIT_V(2); PG8_BAR;
    PG8_STAGE(PG8_SB(1, 0), cB + kstep, voffB); PG8_STAGE(PG8_SA(1, 0), cA + kstep, voffA); PG8_STAGE(PG8_SB(1, 1), cB + hstepB + kstep, voffB);
    PG8_WAIT_V(6); PG8_BAR;
    for (;;) {
        const bool has_next = S.next(ui + 1, nxt);
        const char* nA = has_next ? (const char*)g.A + (size_t)nxt.pm * tstepA : cA; const char* nB = has_next ? (const char*)g.Bt + (size_t)nxt.pn * tstepB : cB;
        for (int t = 0; t < nt; t += 2) {
            const bool last = (t == nt - 2);
            const char* a1 = cA + (size_t)(t + 1) * kstep;
            const char* a2 = last ? nA : cA + (size_t)(t + 2) * kstep; const char* b2 = last ? nB : cB + (size_t)(t + 2) * kstep;
            const char* a3 = a2 + kstep; const char* b3 = b2 + kstep;
            PG8_LDB(B0, 0, 0); PG8_LDB(B1, 0, 1); PG8_SCHED; PG8_LDA(At, 0, 0); PG8_STAGE(PG8_SA(1, 1), a1 + hstepA, voffA);
            PG8_WAIT_V(8); PG8_WAIT_L(0); PG8_BAR; PG8_MMA(0, 0, At, B0); PG8_MMA(0, 1, At, B1); PG8_BAR; PG8_SCHED;
            PG8_LDA(At, 0, 1); PG8_STAGE(PG8_SB(0, 0), b2, voffB); PG8_STAGE(PG8_SB(0, 1), b2 + hstepB, voffB); PG8_STAGE(PG8_SA(0, 0), a2, voffA);
            PG8_WAIT_V(8); PG8_WAIT_L(0); PG8_BAR; PG8_MMA(1, 0, At, B0); PG8_MMA(1, 1, At, B1); PG8_BAR; PG8_SCHED;
            PG8_LDB(B0, 1, 0); PG8_LDB(B1, 1, 1); PG8_SCHED; PG8_LDA(At, 1, 0); PG8_STAGE(PG8_SA(0, 1), a2 + hstepA, voffA);
            PG8_WAIT_V(8); PG8_WAIT_L(0); PG8_BAR; PG8_MMA(0, 0, At, B0); PG8_MMA(0, 1, At, B1); PG8_BAR; PG8_SCHED;
            PG8_LDA(At, 1, 1); PG8_STAGE(PG8_SB(1, 0), b3, voffB); PG8_STAGE(PG8_SB(1, 1), b3 + hstepB, voffB); PG8_STAGE(PG8_SA(1, 0), a3, voffA);
            PG8_WAIT_V(8); PG8_WAIT_L(0); PG8_BAR; PG8_MMA(1, 0, At, B0); PG8_MMA(1, 1, At, B1); PG8_BAR; PG8_SCHED;
        }
        if (wr == 0) PG8_BAR;
        E(acc, cur, wr, wc, fr, fq);
        if (!has_next) break;
#pragma unroll
        for (int a = 0; a < 2; ++a)
#pragma unroll
            for (int b = 0; b < 2; ++b)
#pragma unroll
                for (int m = 0; m < 4; ++m)
#pragma unroll
                    for (int n = 0; n < 2; ++n) acc[a][b][m][n] = (f32x4){0.f, 0.f, 0.f, 0.f};
        cur = nxt; cA = nA; cB = nB; ++ui;
        if (wr == 1) PG8_BAR;
    }
    PG8_WAIT_V(0);
    PG8_BAR;
#undef PG8_SA
#undef PG8_SB
#undef PG8_STAGE
#undef PG8_LDA
#undef PG8_LDB
#undef PG8_MMA
#undef PG8_WAIT_V
#undef PG8_WAIT_L
#undef PG8_BAR
#undef PG8_SCHED
}
}

constexpr int DM = 1024, NB = 8, SEQ = 4096, DEPTH = 4, T = NB * SEQ;
constexpr int DIN = 6072, ZP = 3072;
constexpr int C_CQ = 0, C_CKV = 384, C_KR = 640, C_U = 672, C_QN = 1696, C_KVN = 2208, C_GN = 2976, C_GM = 3000;
constexpr float EPS = 1e-6f, THETA = 500000.0f;
constexpr int NWAVES = 8, NTHR = 512;
constexpr float SC_NSA = 0.125f * 1.4426950408889634f, SC_MLA = 0.10206207261596577f * 1.4426950408889634f;

constexpr size_t MiB = 1u << 20;
constexpr size_t WS_SS1 = 1 * MiB, WS_SS2 = 1 * MiB + 256 * 1024;
constexpr size_t WS_WT = 2 * MiB;
constexpr size_t WT_IN = WS_WT, WT_G = WS_WT + 6 * MiB, WT_UQ = WS_WT + 12 * MiB, WT_UKV = WS_WT + 13 * MiB, WT_OMLA = WS_WT + 14 * MiB  ,
                 WT_CONV = WS_WT + 16 * MiB, WT_ONSA = WS_WT + 17 * MiB, WT_OUT3 = WS_WT + 18 * MiB, WT_FF1 = WS_WT + 20 * MiB, WT_FF2 = WS_WT + 28 * MiB, WT_CMP = WS_WT + 36 * MiB;
constexpr size_t WS_Z = 39 * MiB;
constexpr size_t WS_QA = 231 * MiB;
constexpr size_t WS_KA = 279 * MiB;
constexpr size_t WS_VA = 327 * MiB;
constexpr size_t WS_H2 = 295 * MiB;
constexpr size_t WS_U = 359 * MiB;
constexpr size_t WS_ON = 391 * MiB;
constexpr size_t WS_OA = WS_ON;
constexpr size_t WS_H1 = 423 * MiB;
constexpr size_t WS_KC = 427 * MiB;
constexpr size_t WS_VC = WS_KC + 512 * 1024;
constexpr size_t WS_HB = 428 * MiB;
constexpr size_t WS_END = 492 * MiB;

constexpr int LDS_BYTES = 147456;
#ifndef PHMASK
#define PHMASK 0xffffffff
#endif
#define PH(k) ((PHMASK >> (k)) & 1)

struct Args { const float* in[30]; float* out; unsigned char* ws; };

DI void tr_item(const float* W, int ldw, int c0, int nvalid, bf16* WT, int ldt, int row_off, int koff, LAS float* scr, int kb, int nb, int lane, const float* gain = nullptr) {
    const int k0 = 64 * kb, n0 = 32 * nb;
    const int n = n0 + (lane & 31);
    float wv[32];
#pragma unroll
    for (int i = 0; i < 32; ++i) { const int kk = 2 * i + (lane >> 5); wv[i] = (n < nvalid) ? W[(size_t)(k0 + kk) * ldw + c0 + n] : 0.f; }
#pragma unroll
    for (int i = 0; i < 32; ++i) { const int kk = 2 * i + (lane >> 5); const float gs = gain ? gain[k0 + kk] : 1.f; scr[kk * 33 + (lane & 31)] = wv[i] * gs; }
    asm volatile("s_waitcnt lgkmcnt(0)" ::: "memory");
    const int c = lane & 7;
#pragma unroll
    for (int j = 0; j < 4; ++j) { const int nn = (lane >> 3) + 8 * j; const LAS float* s = scr + (8 * c) * 33 + nn;
        u32x4 o; o.x = pk2(s[0 * 33], s[1 * 33]); o.y = pk2(s[2 * 33], s[3 * 33]); o.z = pk2(s[4 * 33], s[5 * 33]); o.w = pk2(s[6 * 33], s[7 * 33]);
        *(u32x4*)(WT + (size_t)(row_off + n0 + nn) * ldt + koff + k0 + 8 * c) = o; }
    asm volatile("s_waitcnt lgkmcnt(0)" ::: "memory");
}

DI void rms_row_1024(const float* xrow, const float* g, bf16* orow, int lane) {
    const f32x4* xr = (const f32x4*)xrow + lane; const f32x4* gr = (const f32x4*)g + lane;
    f32x4 v[4]; float s = 0.f;
#pragma unroll
    for (int j = 0; j < 4; ++j) { v[j] = xr[64 * j]; s += (v[j].x * v[j].x + v[j].y * v[j].y) + (v[j].z * v[j].z + v[j].w * v[j].w); }
    const float r = rsqrtf(wave_sum(s) * (1.f / 1024.f) + EPS);
    u32x2* o8 = (u32x2*)orow + lane;
#pragma unroll
    for (int j = 0; j < 4; ++j) { const f32x4 gg = gr[64 * j]; u32x2 w; w.x = pk2(v[j].x * r * gg.x, v[j].y * r * gg.y); w.y = pk2(v[j].z * r * gg.z, v[j].w * r * gg.w); o8[64 * j] = w; }
}

DI float raw_row_1024(const float* xrow, bf16* orow, int lane) {
    const f32x4* xr = (const f32x4*)xrow + lane;
    f32x4 v[4]; float s = 0.f;
#pragma unroll
    for (int j = 0; j < 4; ++j) { v[j] = xr[64 * j]; s += (v[j].x * v[j].x + v[j].y * v[j].y) + (v[j].z * v[j].z + v[j].w * v[j].w); }
    u32x2* o8 = (u32x2*)orow + lane;
    s = 0.f;
#pragma unroll
    for (int j = 0; j < 4; ++j) { u32x2 w; w.x = pk2(v[j].x, v[j].y); w.y = pk2(v[j].z, v[j].w); o8[64 * j] = w;
        const float q0 = bflo(w.x), q1 = bfhi(w.x), q2 = bflo(w.y), q3 = bfhi(w.y); s += (q0 * q0 + q1 * q1) + (q2 * q2 + q3 * q3); }
    return wave_sum(s);
}
DI void rope_cs(int pos, int i, int rot_dim, float& c, float& s) {
    const float inv = powf(THETA, -(float)i * (2.0f / (float)rot_dim));
    const float ang = (float)pos * inv;
    sincosf(ang, &s, &c);
}

constexpr size_t WS_ROPE_N = 64 * 1024;
constexpr size_t WS_ROPE_M = WS_ROPE_N + 4096 * 16 * 4;
DI float ssq8(const float (&f)[8]) { return ((f[0] * f[0] + f[1] * f[1]) + (f[2] * f[2] + f[3] * f[3])) + ((f[4] * f[4] + f[5] * f[5]) + (f[6] * f[6] + f[7] * f[7])); }
DI u32x4 nsa_head_chunk(const u32x4 w, const float* gain, const float* rt  , int lane, float oscale = 1.0f) {
    float q[8]; unpack8(w, q);
    float ss = ssq8(q); ss += __shfl_xor(ss, 1); ss += __shfl_xor(ss, 2); ss += __shfl_xor(ss, 4);
    const float r = rsqrtf(ss * (1.f / 64.f) + EPS) * oscale;
    const int sub = lane & 7;
    float g[8]; load8f(gain + 8 * sub, g);
    float y[8], p[8];
#pragma unroll
    for (int e = 0; e < 8; ++e) y[e] = q[e] * r * g[e];
#pragma unroll
    for (int e = 0; e < 8; ++e) p[e] = __shfl_xor(y[e], 1);
    if (sub < 2) {
        float c[8], s[8]; load8f(rt, c); load8f(rt + 8, s);
#pragma unroll
        for (int e = 0; e < 8; ++e) y[e] = (sub == 0) ? (y[e] * c[e] - p[e] * s[e]) : (y[e] * c[e] + p[e] * s[e]);
    }
    return pack8(y);
}
DI u32x4 mla_head_chunk(const u32x4 w, const float* gain, const float* rt  , int lane, float oscale = 1.0f) {
    const int sub = lane & 15;
    float q[8]; unpack8(w, q);
    float ss = ssq8(q); ss += __shfl_xor(ss, 1); ss += __shfl_xor(ss, 2); ss += __shfl_xor(ss, 4); ss += __shfl_xor(ss, 8);
    const float r = rsqrtf(ss * (1.f / 96.f) + EPS) * oscale;
    float g[8]; load8f(gain + 8 * (sub < 12 ? sub : 0), g);
    float y[8], p[8];
#pragma unroll
    for (int e = 0; e < 8; ++e) y[e] = q[e] * r * g[e];
#pragma unroll
    for (int e = 0; e < 8; ++e) p[e] = __shfl_xor(y[e], 2);
    if (sub < 4) {
        float c[8], s[8]; load8f(rt + 8 * (sub & 1), c); load8f(rt + 16 + 8 * (sub & 1), s);
#pragma unroll
        for (int e = 0; e < 8; ++e) y[e] = (sub < 2) ? (y[e] * c[e] - p[e] * s[e]) : (y[e] * c[e] + p[e] * s[e]);
    }
    return pack8(y);
}

#define MFMA32(a, b, c) __builtin_amdgcn_mfma_f32_32x32x16_bf16((a), (b), (c), 0, 0, 0)
DI int crow(int i, int h) { return (i & 3) + 8 * (i >> 2) + 4 * h; }
typedef short v4i16_t __attribute__((ext_vector_type(4)));
DI s16x4 vtr(const LAS char* p) { return __builtin_bit_cast(s16x4, __builtin_amdgcn_ds_read_tr16_b64_v4i16((LAS v4i16_t*)p)); }

constexpr int VP = 144;
constexpr int ATT_KSZ = 13312, ATT_VSZ = 9216;
constexpr int ATT_K_OFF = 0;
constexpr int ATT_V_OFF = 2 * ATT_KSZ;
constexpr int ATT_IMP_OFF = 49152;
constexpr int ATT_SEL_OFF = 49152 + 65536;
static_assert(ATT_V_OFF + 2 * ATT_VSZ <= ATT_IMP_OFF, "attention LDS map");

DI float fexp2(float x) { return __builtin_amdgcn_exp2f(x); }
DI float xhalf_max(float v) { auto rr = __builtin_amdgcn_permlane32_swap(__float_as_uint(v), __float_as_uint(v), false, false); return fmaxf(__uint_as_float(rr[0]), __uint_as_float(rr[1])); }
DI float xhalf_sum(float v) { auto rr = __builtin_amdgcn_permlane32_swap(__float_as_uint(v), __float_as_uint(v), false, false); return __uint_as_float(rr[0]) + __uint_as_float(rr[1]); }
DI void lds_barrier() { asm volatile("s_waitcnt lgkmcnt(0)" ::: "memory"); __builtin_amdgcn_s_barrier(); asm volatile("" ::: "memory"); }

template <int DQK, int MODE, class Mask>
DI void flash_pass(LAS char* lds, const bf16* Kg, size_t kpitch, const bf16* Vg, size_t vpitch, int tile_lo, int tile_hi, int wave_tile_hi,
                   const bf16x8 (&qf)[DQK / 16], float sc, const Mask& mask, float& m_run, float& l_run, f32x16 (&o)[2],
                   LAS float* imp_row  , int tid, int lane) {
    constexpr int NKS = DQK / 16, KP = DQK * 2 + 16, KCH = DQK / 8, NCH = 64 * KCH;
    const int r = lane & 31, h = lane >> 5;
    u32x4 kreg0, kreg1 = (u32x4){0, 0, 0, 0}, vreg = (u32x4){0, 0, 0, 0};
    const int krow0 = tid / KCH, kc0 = tid % KCH, krow1 = (tid + 512) / KCH, kc1 = (tid + 512) % KCH;
    const int vkey = tid >> 3, vc = tid & 7;
    float prev = 0.f; (void)prev;
    const float inv_l = (MODE == 2) ? l_run : 0.f; (void)inv_l;
    if (tile_lo >= tile_hi) return;
#define FP_GLOAD(jt) do { const size_t k0_ = (size_t)(jt) * 64; \
        kreg0 = *(const u32x4*)(Kg + (k0_ + krow0) * kpitch + kc0 * 8); \
        if (NCH > 512 && tid + 512 < NCH) kreg1 = *(const u32x4*)(Kg + (k0_ + krow1) * kpitch + kc1 * 8); \
        if (MODE != 1) vreg = *(const u32x4*)(Vg + (k0_ + vkey) * vpitch + vc * 8); } while (0)
#define FP_LSTORE(buf) do { LAS char* Kd_ = lds + ATT_K_OFF + (buf) * ATT_KSZ; LAS char* Vd_ = lds + ATT_V_OFF + (buf) * ATT_VSZ; \
        *(LAS u32x4*)(Kd_ + krow0 * KP + kc0 * 16) = kreg0; \
        if (NCH > 512 && tid + 512 < NCH) *(LAS u32x4*)(Kd_ + krow1 * KP + kc1 * 16) = kreg1; \
        if (MODE != 1) *(LAS u32x4*)(Vd_ + vkey * VP + vc * 16) = vreg; } while (0)
    FP_GLOAD(tile_lo);
    {
        u32x4 nk0 = (u32x4){0, 0, 0, 0}, nk1 = (u32x4){0, 0, 0, 0}, nv = (u32x4){0, 0, 0, 0};
        const bool two = tile_lo + 1 < tile_hi;
        if (two) { const size_t k0_ = (size_t)(tile_lo + 1) * 64;
            nk0 = *(const u32x4*)(Kg + (k0_ + krow0) * kpitch + kc0 * 8);
            if (NCH > 512 && tid + 512 < NCH) nk1 = *(const u32x4*)(Kg + (k0_ + krow1) * kpitch + kc1 * 8);
            if (MODE != 1) nv = *(const u32x4*)(Vg + (k0_ + vkey) * vpitch + vc * 8); }
        lds_barrier();
        FP_LSTORE(0);
        if (two) { kreg0 = nk0; kreg1 = nk1; vreg = nv; }
    }
    lds_barrier();
    float mref = 0.f; bool href = false;
    if (MODE == 2) { mref = m_run; href = true; }
    f32x16 negm16, ol;
#pragma unroll
    for (int i = 0; i < 16; ++i) { negm16[i] = -mref; ol[i] = 0.f; }
    const bf16x8 ones8 = (bf16x8){0x3f80, 0x3f80, 0x3f80, 0x3f80, 0x3f80, 0x3f80, 0x3f80, 0x3f80};
    for (int j = tile_lo; j < tile_hi; ++j) {
        const int cur = (j - tile_lo) & 1;
        if (j + 1 < tile_hi) FP_LSTORE(cur ^ 1);
        if (j + 2 < tile_hi) FP_GLOAD(j + 2);
        if (j < wave_tile_hi) {
            const LAS char* Ks = lds + ATT_K_OFF + cur * ATT_KSZ; const LAS char* Vs = lds + ATT_V_OFF + cur * ATT_VSZ;
            bf16x8 kf[2][NKS];
#pragma unroll
            for (int kb = 0; kb < 2; ++kb)
#pragma unroll
                for (int kk = 0; kk < NKS; ++kk) kf[kb][kk] = *(const LAS bf16x8*)(Ks + (32 * kb + r) * KP + (16 * kk + 8 * h) * 2);
            __builtin_amdgcn_sched_barrier(0);
            f32x16 s[2];
            asm volatile("v_mfma_f32_32x32x16_bf16 %0, %1, %2, %3" : "=&v"(s[0]) : "v"(kf[0][0]), "v"(qf[0]), "v"(negm16));
            asm volatile("v_mfma_f32_32x32x16_bf16 %0, %1, %2, %3" : "=&v"(s[1]) : "v"(kf[1][0]), "v"(qf[0]), "v"(negm16));
#pragma unroll
            for (int kk = 1; kk < NKS; ++kk) {
                s[0] = MFMA32(kf[0][kk], qf[kk], s[0]);
                s[1] = MFMA32(kf[1][kk], qf[kk], s[1]);
            }
            __builtin_amdgcn_sched_barrier(0);
            s16x4 vlo[2][2][2], vhi[2][2][2];
            if (MODE != 1) {
                const int q4 = (lane & 15) >> 2, p4 = lane & 3, blk = (lane >> 4) & 1;
                const LAS char* vb0 = Vs + (4 * h + q4) * VP + (16 * blk) * 2 + 8 * p4;
#pragma unroll
                for (int kb = 0; kb < 2; ++kb)
#pragma unroll
                    for (int s2 = 0; s2 < 2; ++s2)
#pragma unroll
                        for (int d = 0; d < 2; ++d) { const LAS char* vb = vb0 + (32 * kb + 16 * s2) * VP + (32 * d) * 2; vlo[kb][s2][d] = vtr(vb); vhi[kb][s2][d] = vtr(vb + 8 * VP); }
            }
            __builtin_amdgcn_sched_barrier(0);
            const int key0 = j * 64 + 4 * h;
            if (mask.needs(j)) {
#pragma unroll
                for (int kb = 0; kb < 2; ++kb)
#pragma unroll
                    for (int i = 0; i < 16; ++i) { const int key = key0 + 32 * kb + (i & 3) + 8 * (i >> 2); s[kb][i] = mask(key, j) ? s[kb][i] : -3e30f; }
            }
            const bool on = mask.lane_on(j);
            if (MODE == 0 || MODE == 1) {
                asm volatile("s_nop 15\n\ts_nop 7" : "+v"(s[0]), "+v"(s[1]));
                float mt, mu;
                asm volatile("v_max3_f32 %0, %1, %2, %3" : "=v"(mt) : "v"(s[0][0]), "v"(s[0][1]), "v"(s[0][2]));
                asm volatile("v_max3_f32 %0, %1, %2, %3" : "=v"(mu) : "v"(s[1][0]), "v"(s[1][1]), "v"(s[1][2]));
#pragma unroll
                for (int i = 3; i < 15; i += 2) {
                    asm volatile("v_max3_f32 %0, %1, %2, %3" : "=v"(mt) : "v"(mt), "v"(s[0][i]), "v"(s[0][i + 1]));
                    asm volatile("v_max3_f32 %0, %1, %2, %3" : "=v"(mu) : "v"(mu), "v"(s[1][i]), "v"(s[1][i + 1]));
                }
                asm volatile("v_max3_f32 %0, %1, %2, %3" : "=v"(mt) : "v"(mt), "v"(s[0][15]), "v"(s[1][15]));
                asm volatile("v_max_f32 %0, %1, %2" : "=v"(mt) : "v"(mt), "v"(mu));
                mt = on ? mt : -3e30f;
                mt = xhalf_max(mt);
                const bool need = (mt > 8.0f) || (!href && mt > -1e29f);
                if (__builtin_amdgcn_ballot_w64(need) != 0ull) {
                    const float dl = need ? mt : 0.f;
                    const float alpha = href ? fexp2(-dl) : 0.f;
                    mref += dl; href = href || need;
#pragma unroll
                    for (int kb = 0; kb < 2; ++kb)
#pragma unroll
                        for (int i = 0; i < 16; ++i) s[kb][i] -= dl;
#pragma unroll
                    for (int i = 0; i < 16; ++i) { negm16[i] = -mref; ol[i] *= alpha; }
                    if (MODE == 0) {
#pragma unroll
                        for (int d = 0; d < 2; ++d)
#pragma unroll
                            for (int i = 0; i < 16; ++i) o[d][i] *= alpha;
                    }
                }
#pragma unroll
                for (int kb = 0; kb < 2; ++kb)
#pragma unroll
                    for (int i = 0; i < 16; ++i) s[kb][i] = fexp2(s[kb][i]);
            } else {
#pragma unroll
                for (int kb = 0; kb < 2; ++kb) {
#pragma unroll
                    for (int i = 0; i < 16; ++i) s[kb][i] = fexp2(s[kb][i]) * inv_l;
#pragma unroll
                    for (int ig = 0; ig < 4; ++ig) {
                        const float g4 = (s[kb][4 * ig] + s[kb][4 * ig + 1]) + (s[kb][4 * ig + 2] + s[kb][4 * ig + 3]);
                        const float pa = __shfl_xor(s[kb][4 * ig + 3], 32);
                        const float extra = h ? pa : prev;
                        prev = pa;
                        imp_row[16 * j + 8 * kb + 2 * ig + h] = g4 + extra;
                    }
                }
            }
#pragma unroll
            for (int kb = 0; kb < 2; ++kb)
#pragma unroll
                for (int s2 = 0; s2 < 2; ++s2) {
                    u32x4 pw; pw.x = pk2(s[kb][8 * s2 + 0], s[kb][8 * s2 + 1]); pw.y = pk2(s[kb][8 * s2 + 2], s[kb][8 * s2 + 3]);
                    pw.z = pk2(s[kb][8 * s2 + 4], s[kb][8 * s2 + 5]); pw.w = pk2(s[kb][8 * s2 + 6], s[kb][8 * s2 + 7]);
                    if (Mask::HAS_OFF) { const unsigned om = on ? 0xffffffffu : 0u; pw.x &= om; pw.y &= om; pw.z &= om; pw.w &= om; }
                    const bf16x8 pf = __builtin_bit_cast(bf16x8, pw);
                    if (MODE != 2) ol = MFMA32(ones8, pf, ol);
                    if (MODE != 1) {
#pragma unroll
                        for (int d = 0; d < 2; ++d) {
                            const s16x4 lo = vlo[kb][s2][d], hi = vhi[kb][s2][d];
                            const bf16x8 a = (bf16x8){lo[0], lo[1], lo[2], lo[3], hi[0], hi[1], hi[2], hi[3]};
                            o[d] = MFMA32(a, pf, o[d]);
                        }
                    }
                }
        }
        lds_barrier();
    }
    if (MODE != 2) { m_run = href ? mref : -1e29f; l_run = ol[0]; }
#undef FP_GLOAD
#undef FP_LSTORE
}

struct MaskCausal { static constexpr bool HAS_OFF = false; int t, q0w; DI bool operator()(int key, int) const { return key <= t; } DI bool needs(int j) const { return 64 * j + 63 > q0w; } DI bool lane_on(int) const { return true; } };
struct MaskCmp { static constexpr bool HAS_OFF = false; int t; DI bool operator()(int key, int) const { return 16 * key + 31 <= t; } DI bool needs(int) const { return true; } DI bool lane_on(int) const { return true; } };
struct MaskSlc { static constexpr bool HAS_OFF = true; int t, qb; unsigned long long sel; DI bool operator()(int key, int) const { return key <= t; } DI bool needs(int j) const { return j == qb; } DI bool lane_on(int j) const { return (sel >> j) & 1ull; } };
struct MaskWin { static constexpr bool HAS_OFF = false; int t, qb; DI bool operator()(int key, int) const { return key <= t && key > t - 512; } DI bool needs(int j) const { return j == qb || j == qb - 8; } DI bool lane_on(int) const { return true; } };

DI f32x16 zero16() { return (f32x16){0.f, 0.f, 0.f, 0.f, 0.f, 0.f, 0.f, 0.f, 0.f, 0.f, 0.f, 0.f, 0.f, 0.f, 0.f, 0.f}; }

DI void mla_unit(LAS char* lds, int b, int hd, int qb, bf16* Qa, const bf16* Ka, const bf16* Va, int tid, int lane, int wave) {
    const int r = lane & 31, h = lane >> 5;
    const size_t m0 = (size_t)b * SEQ;
    const int q0 = qb * 256 + wave * 32;
    const int t = q0 + r;
    bf16x8 qf[6];
#pragma unroll
    for (int kk = 0; kk < 6; ++kk) qf[kk] = *(const bf16x8*)(Qa + (m0 + t) * 768 + hd * 96 + 16 * kk + 8 * h);
    float m_run = -1e29f, l_run = 0.f; f32x16 o[2]; o[0] = zero16(); o[1] = zero16();
    const float sc = 0.10206207261596577f * 1.4426950408889634f;
    MaskCausal mk{t, q0};
    flash_pass<96, 0>(lds, Ka + m0 * 768 + hd * 96, 768, Va + m0 * 512 + hd * 64, 512, 0, 4 * qb + 4, (q0 + 31) / 64 + 1, qf, sc, mk, m_run, l_run, o, (LAS float*)nullptr, tid, lane);
    const float il = 1.0f / l_run;
    bf16* orow = Qa + (m0 + t) * 768 + hd * 96;
#pragma unroll
    for (int d = 0; d < 2; ++d)
#pragma unroll
        for (int ig = 0; ig < 4; ++ig) {
            u32x2 w; w.x = pk2(o[d][4 * ig] * il, o[d][4 * ig + 1] * il); w.y = pk2(o[d][4 * ig + 2] * il, o[d][4 * ig + 3] * il);
            *(u32x2*)(orow + 32 * d + 8 * ig + 4 * h) = w;
        }
}

DI void nsa_unit(LAS char* lds, int b, int g, int qb, const bf16* Z, const bf16* KC, const bf16* VC, bf16* On, int tid, int lane, int wave) {
    const int r = lane & 31, h = lane >> 5;
    const size_t m0 = (size_t)b * SEQ;
    const int hd = g * 4 + (wave >> 1), hl = wave >> 1, qloc = (wave & 1) * 32 + r;
    const int t = qb * 64 + qloc;
    const bf16* zrow = Z + (m0 + t) * ZP;
    bf16x8 qf[4];
#pragma unroll
    for (int kk = 0; kk < 4; ++kk) qf[kk] = *(const bf16x8*)(zrow + C_QN + hd * 64 + 16 * kk + 8 * h);
    const float g0 = sigmoidf_(bf2f(zrow[C_GN + hd * 3 + 0])), g1 = sigmoidf_(bf2f(zrow[C_GN + hd * 3 + 1])), g2 = sigmoidf_(bf2f(zrow[C_GN + hd * 3 + 2]));
    const float sc = 0.125f * 1.4426950408889634f;
    LAS float* stash = (LAS float*)(lds + ATT_IMP_OFF) + wave * 2048 + lane;
    f32x16 o[2];
    LAS float* impH = (LAS float*)(lds + ATT_IMP_OFF);
    LAS unsigned long long* selm = (LAS unsigned long long*)(lds + ATT_SEL_OFF);
    {
        const bf16* Kc = KC + (size_t)(b * 2 + g) * 256 * 64; const bf16* Vc = VC + (size_t)(b * 2 + g) * 256 * 64;
        const int cmax = (qb * 64 + 32) / 16;
        const int ntile = cmax / 64 + 1;
        MaskCmp mk{t};
        float m_run = -1e29f, l_run = 0.f; o[0] = zero16(); o[1] = zero16();
        flash_pass<64, 1>(lds, Kc, 64, Vc, 64, 0, ntile, ntile, qf, sc, mk, m_run, l_run, o, (LAS float*)nullptr, tid, lane);
        float il = (l_run > 0.f && m_run > -1e28f) ? 1.0f / l_run : 0.f;
        float mfix = (m_run > -1e28f) ? m_run : 0.f;
        flash_pass<64, 2>(lds, Kc, 64, Vc, 64, 0, ntile, ntile, qf, sc, mk, mfix, il, o, impH + (hl * 64 + qloc) * 64, tid, lane);
    }
    __syncthreads();
    {
        const int n = lane;
#pragma unroll 1
        for (int qi = 0; qi < 8; ++qi) {
            const int q = wave * 8 + qi;
            float v = -INFINITY;
            if (n <= qb) {
                v = ((impH[(0 * 64 + q) * 64 + n] + impH[(1 * 64 + q) * 64 + n]) + impH[(2 * 64 + q) * 64 + n]) + impH[(3 * 64 + q) * 64 + n];
                if (n == 0 || n == qb || n == qb - 1) v = 1e6f;
            }
            LAS float* vs = (LAS float*)(lds + ATT_SEL_OFF + 512) + wave * 64;
            vs[n] = v;
            int cnt = 0;
#pragma unroll 4
            for (int m4 = 0; m4 < 16; ++m4) {
                const f32x4 vm = *(const LAS f32x4*)(vs + 4 * m4);
#pragma unroll
                for (int e = 0; e < 4; ++e) { const int m = 4 * m4 + e; cnt += (vm[e] > v || (vm[e] == v && m < n)) ? 1 : 0; }
            }
            const bool sel = (cnt < 16) && (n <= qb);
            const unsigned long long mk = __ballot(sel);
            if (lane == 0) selm[q] = mk;
        }
    }
    __syncthreads();
#pragma unroll
    for (int d = 0; d < 2; ++d)
#pragma unroll
        for (int i = 0; i < 16; ++i) stash[(d * 16 + i) * 64] = g0 * o[d][i];
    {
        const unsigned long long sel = selm[qloc];
        MaskSlc mk{t, qb, sel};
        float m_run = -1e29f, l_run = 0.f; o[0] = zero16(); o[1] = zero16();
        const bf16* Kg = Z + m0 * ZP + C_KVN + 2 * 128 + g * 64; const bf16* Vg = Z + m0 * ZP + C_KVN + 3 * 128 + g * 64;
        flash_pass<64, 0>(lds, Kg, ZP, Vg, ZP, 0, qb + 1, qb + 1, qf, sc, mk, m_run, l_run, o, (LAS float*)nullptr, tid, lane);
        const float w = g1 / l_run;
#pragma unroll
        for (int d = 0; d < 2; ++d)
#pragma unroll
            for (int i = 0; i < 16; ++i) stash[(d * 16 + i) * 64] += w * o[d][i];
    }
    {
        MaskWin mk{t, qb};
        float m_run = -1e29f, l_run = 0.f; o[0] = zero16(); o[1] = zero16();
        const bf16* Kg = Z + m0 * ZP + C_KVN + 4 * 128 + g * 64; const bf16* Vg = Z + m0 * ZP + C_KVN + 5 * 128 + g * 64;
        const int lo = qb - 8 > 0 ? qb - 8 : 0;
        flash_pass<64, 0>(lds, Kg, ZP, Vg, ZP, lo, qb + 1, qb + 1, qf, sc, mk, m_run, l_run, o, (LAS float*)nullptr, tid, lane);
        const float w = g2 / l_run;
#pragma unroll
        for (int d = 0; d < 2; ++d)
#pragma unroll
            for (int i = 0; i < 16; ++i) o[d][i] = stash[(d * 16 + i) * 64] + w * o[d][i];
    }
    bf16* orow = On + (m0 + t) * 512 + hd * 64;
#pragma unroll
    for (int d = 0; d < 2; ++d)
#pragma unroll
        for (int ig = 0; ig < 4; ++ig) {
            u32x2 w; w.x = pk2(o[d][4 * ig], o[d][4 * ig + 1]); w.y = pk2(o[d][4 * ig + 2], o[d][4 * ig + 3]);
            *(u32x2*)(orow + 32 * d + 8 * ig + 4 * h) = w;
        }
    __syncthreads();
}

constexpr float SS_FIX = 16777216.0f;
DI float rscale(const float* ss, int row) { const unsigned long long v = ((const unsigned long long*)ss)[row]; return rsqrtf((float)v * (1.0f / SS_FIX) * (1.f / 1024.f) + EPS); }

struct FStoreBf16 { bf16* O; int ldc;
    DI float rowctx(int) const { return 1.f; }
    DI void operator()(int row, int col, f32x4 a, f32x4 b, float rc) const { u32x4 w; w.x = pk2(a[0], a[1]); w.y = pk2(a[2], a[3]); w.z = pk2(b[0], b[1]); w.w = pk2(b[2], b[3]); *(u32x4*)(O + (size_t)row * ldc + col) = w; } };
struct FStoreKV { bf16* Ka; bf16* Va;
    DI float rowctx(int) const { return 1.f; }
    DI void operator()(int row, int col, f32x4 a, f32x4 b, float rc) const { u32x4 w; w.x = pk2(a[0], a[1]); w.y = pk2(a[2], a[3]); w.z = pk2(b[0], b[1]); w.w = pk2(b[2], b[3]);
        const int hd = col >> 7, c = col & 127;
        if (c < 64) *(u32x4*)(Ka + (size_t)row * 768 + hd * 96 + 32 + c) = w; else *(u32x4*)(Va + (size_t)row * 512 + hd * 64 + (c - 64)) = w; } };
struct FSilu { bf16* O; int ldc;
    DI float rowctx(int) const { return 1.f; }
    DI void operator()(int row, int col, f32x4 a, f32x4 b, float rc) const {
#pragma unroll
        for (int i = 0; i < 4; ++i) { a[i] = a[i] * sigmoidf_(a[i]); b[i] = b[i] * sigmoidf_(b[i]); }
        u32x4 w; w.x = pk2(a[0], a[1]); w.y = pk2(a[2], a[3]); w.z = pk2(b[0], b[1]); w.w = pk2(b[2], b[3]); *(u32x4*)(O + (size_t)row * ldc + col) = w; } };
struct FStoreBias { bf16* O; int ldc; int coloff; const float* bias;
    DI float rowctx(int) const { return 1.f; }
    DI void operator()(int row, int col, f32x4 a, f32x4 b, float rc) const {
        if (bias) { const f32x4 b0 = *(const f32x4*)(bias + col), b1 = *(const f32x4*)(bias + col + 4); a += b0; b += b1; }
        u32x4 w; w.x = pk2(a[0], a[1]); w.y = pk2(a[2], a[3]); w.z = pk2(b[0], b[1]); w.w = pk2(b[2], b[3]); *(u32x4*)(O + (size_t)row * ldc + coloff + col) = w; } };
struct FGateMul { bf16* P; int ldc; const float* ss;
    DI float rowctx(int row) const { return rscale(ss, row); }
    DI void operator()(int row, int col, f32x4 a, f32x4 b, float rc) const {
        const int mix = col >> 10, c = col & 1023;
        a *= rc; b *= rc;
        const u32x4 ov = *(const u32x4*)(P + (size_t)row * ldc + col);
        float o[8]; unpack8(ov, o);
        float acc[8] = {0.f, 0.f, 0.f, 0.f, 0.f, 0.f, 0.f, 0.f};
        u32x4* slot = (u32x4*)(P + (size_t)row * ldc + c);
        if (mix) { const u32x4 sv = *slot; unpack8(sv, acc); }
        acc[0] += sigmoidf_(a[0]) * o[0]; acc[1] += sigmoidf_(a[1]) * o[1]; acc[2] += sigmoidf_(a[2]) * o[2]; acc[3] += sigmoidf_(a[3]) * o[3];
        acc[4] += sigmoidf_(b[0]) * o[4]; acc[5] += sigmoidf_(b[1]) * o[5]; acc[6] += sigmoidf_(b[2]) * o[6]; acc[7] += sigmoidf_(b[3]) * o[7];
        *slot = pack8(acc); } };
struct EpiGate {
    static constexpr bool PERM = true;
    bf16* P; int ldc; const float* ss;
    __device__ __forceinline__ void operator()(const f32x4 (&acc)[2][2][4][2], const pg8::Unit& u, int wr, int wc, int fr, int fq) const {
        const int row0 = u.pm * pg8::BM + wr * 64 + fr, col0 = u.pn * pg8::BM + wc * 32 + 8 * fq;
        const int mix = u.pn >> 2;
#pragma unroll
        for (int ai = 0; ai < 2; ++ai) {
            u32x4 ov[4][2], sv[4][2]; float rc[4];
#pragma unroll
            for (int m = 0; m < 4; ++m) {
                const int row = row0 + ai * pg8::HALF + m * 16;
#pragma unroll
                for (int bj = 0; bj < 2; ++bj) {
                    const int col = col0 + bj * pg8::HALF;
                    ov[m][bj] = *(const u32x4*)(P + (size_t)row * ldc + col);
                    sv[m][bj] = (u32x4){0, 0, 0, 0};
                    if (mix) sv[m][bj] = *(const u32x4*)(P + (size_t)row * ldc + (col & 1023));
                }
                rc[m] = rscale(ss, row);
            }
#pragma unroll
            for (int m = 0; m < 4; ++m) {
                const int row = row0 + ai * pg8::HALF + m * 16;
#pragma unroll
                for (int bj = 0; bj < 2; ++bj) {
                    const int col = col0 + bj * pg8::HALF;
                    const f32x4 a = acc[ai][bj][m][0] * rc[m], b = acc[ai][bj][m][1] * rc[m];
                    float o[8], s[8]; unpack8(ov[m][bj], o); unpack8(sv[m][bj], s);
                    s[0] += sigmoidf_(a[0]) * o[0]; s[1] += sigmoidf_(a[1]) * o[1]; s[2] += sigmoidf_(a[2]) * o[2]; s[3] += sigmoidf_(a[3]) * o[3];
                    s[4] += sigmoidf_(b[0]) * o[4]; s[5] += sigmoidf_(b[1]) * o[5]; s[6] += sigmoidf_(b[2]) * o[6]; s[7] += sigmoidf_(b[3]) * o[7];
                    *(u32x4*)(P + (size_t)row * ldc + (col & 1023)) = pack8(s);
                }
            }
        }
    }
};
struct FScaleStore { bf16* O; int ldc; const float* ss;
    DI float rowctx(int row) const { return rscale(ss, row); }
    DI void operator()(int row, int col, f32x4 a, f32x4 b, float rc) const { a *= rc; b *= rc;
        u32x4 w; w.x = pk2(a[0], a[1]); w.y = pk2(a[2], a[3]); w.z = pk2(b[0], b[1]); w.w = pk2(b[2], b[3]); *(u32x4*)(O + (size_t)row * ldc + col) = w; } };
struct FRelu2S { bf16* O; int ldc; const float* ss;
    DI float rowctx(int row) const { return rscale(ss, row); }
    DI void operator()(int row, int col, f32x4 a, f32x4 b, float rc) const {
#pragma unroll
        for (int i = 0; i < 4; ++i) { const float x = fmaxf(a[i] * rc, 0.f), y = fmaxf(b[i] * rc, 0.f); a[i] = x * x; b[i] = y * y; }
        u32x4 w; w.x = pk2(a[0], a[1]); w.y = pk2(a[2], a[3]); w.z = pk2(b[0], b[1]); w.w = pk2(b[2], b[3]); *(u32x4*)(O + (size_t)row * ldc + col) = w; } };
struct EpiResidStats {
    static constexpr bool PERM = true;
    const bf16* rin; bf16* rout; float* fout; float* ss;
    __device__ __forceinline__ void operator()(const f32x4 (&acc)[2][2][4][2], const pg8::Unit& u, int wr, int wc, int fr, int fq) const {
        const int row0 = u.pm * pg8::BM + wr * 64 + fr, col0 = u.pn * pg8::BM + wc * 32 + 8 * fq;
#pragma unroll
        for (int ai = 0; ai < 2; ++ai) {
            u32x4 rv[4][2];
#pragma unroll
            for (int m = 0; m < 4; ++m)
#pragma unroll
                for (int bj = 0; bj < 2; ++bj) rv[m][bj] = *(const u32x4*)(rin + (row0 + ai * pg8::HALF + m * 16) * DM + col0 + bj * pg8::HALF);
#pragma unroll
            for (int m = 0; m < 4; ++m) {
                const int row = row0 + ai * pg8::HALF + m * 16;
                float part = 0.f;
#pragma unroll
                for (int bj = 0; bj < 2; ++bj) {
                    const int off = row * DM + col0 + bj * pg8::HALF;
                    float xr[8]; unpack8(rv[m][bj], xr);
                    const f32x4 a0 = acc[ai][bj][m][0], a1 = acc[ai][bj][m][1];
                    float xn[8] = {xr[0] + a0[0], xr[1] + a0[1], xr[2] + a0[2], xr[3] + a0[3], xr[4] + a1[0], xr[5] + a1[1], xr[6] + a1[2], xr[7] + a1[3]};
                    if (fout) { *(f32x4*)(fout + off) = (f32x4){xn[0], xn[1], xn[2], xn[3]}; *(f32x4*)(fout + off + 4) = (f32x4){xn[4], xn[5], xn[6], xn[7]}; }
                    const u32x4 w = pack8(xn);
                    *(u32x4*)(rout + off) = w;
                    float xq[8]; unpack8(w, xq);
                    part += ssq8(xq);
                }
                part += __shfl_xor(part, 16); part += __shfl_xor(part, 32);
                if (fq == 0) atomicAdd((unsigned long long*)ss + row, (unsigned long long)(part * SS_FIX + 0.5f));
            }
        }
    }
};
struct FResid { const float* xin; float* out;
    DI float rowctx(int) const { return 1.f; }
    DI void operator()(int row, int col, f32x4 a, f32x4 b, float rc) const {
        const f32x4* xi = (const f32x4*)(xin + (size_t)row * DM + col); f32x4* xo = (f32x4*)(out + (size_t)row * DM + col);
        const f32x4 x0 = xi[0], x1 = xi[1]; xo[0] = x0 + a; xo[1] = x1 + b; } };
struct FRelu2 { bf16* O; int ldc;
    DI void operator()(int row, int col, f32x4 a, f32x4 b) const {
#pragma unroll
        for (int i = 0; i < 4; ++i) { const float x = fmaxf(a[i], 0.f), y = fmaxf(b[i], 0.f); a[i] = x * x; b[i] = y * y; }
        u32x4 w; w.x = pk2(a[0], a[1]); w.y = pk2(a[2], a[3]); w.z = pk2(b[0], b[1]); w.w = pk2(b[2], b[3]); *(u32x4*)(O + (size_t)row * ldc + col) = w; } };

template <class E>
DI void run_gemm_epi(LAS unsigned char* lds, const bf16* A, int lda, const bf16* Bt, int M, int N, int K, const E& e) {
    pg8::Gemm g{A, Bt, M, N, K, lda}; pg8::StaticOrder S; S.init(M, N, (int)gridDim.x, (int)blockIdx.x);
    pg8::gemm_phase<E, pg8::StaticOrder>(lds, g, S, e);
}
template <class F>
DI void run_gemm_sub(LAS unsigned char* lds, const bf16* A, int lda, const bf16* Bt, int M, int N, int K, const F& f, int Geff, int ceff) {
    pg8::Gemm g{A, Bt, M, N, K, lda}; pg8::StaticOrder S; S.init(M, N, Geff, ceff);
    pg8::EpiF<F> E{f};
    pg8::gemm_phase<pg8::EpiF<F>, pg8::StaticOrder>(lds, g, S, E);
}
template <class E>
DI void run_gemm_triple(LAS unsigned char* lds, const bf16* A, int lda, const bf16* Bt, int M, int N, int K, const E& e) {
    pg8::Gemm g{A, Bt, M, N, K, lda}; pg8::TripleOrder S; S.init(M, (int)gridDim.x, (int)blockIdx.x);
    pg8::gemm_phase<E, pg8::TripleOrder>(lds, g, S, e);
}
template <class F>
DI void run_gemm(LAS unsigned char* lds, const bf16* A, int lda, const bf16* Bt, int M, int N, int K, const F& f) {
    pg8::Gemm g{A, Bt, M, N, K, lda}; pg8::StaticOrder S; S.init(M, N, (int)gridDim.x, (int)blockIdx.x);
    pg8::EpiF<F> E{f};
    pg8::gemm_phase<pg8::EpiF<F>, pg8::StaticOrder>(lds, g, S, E);
}


#define XB_TMO      128
#define XB_XCNT(j)  (256  + 64 * (j))
#define XB_XSUB(j)  (1280 + 64 * (j))
#define XB_XGEN(j)  (2304 + 64 * (j))
#define XB_TOP      3328
#define XB_TOPGEN   3392
#define XCD_BAR_WORDS 3456
#define XB_SPIN_CAP (1u << 22)
DI unsigned xb_ld(unsigned* p)              { return __hip_atomic_load(p, __ATOMIC_RELAXED, __HIP_MEMORY_SCOPE_AGENT); }
DI unsigned xb_add(unsigned* p, unsigned v) { return __hip_atomic_fetch_add(p, v, __ATOMIC_RELAXED, __HIP_MEMORY_SCOPE_AGENT); }
DI unsigned xb_xcc_id() { return (unsigned)__builtin_amdgcn_s_getreg((3 << 11) | 20) & 0xFu; }
#define XB_SPIN(cond, bar) do { unsigned _sp = 0; while (cond) { __builtin_amdgcn_s_sleep(1); \
    if ((++_sp & 255u) == 0u) { if (xb_ld(&(bar)[XB_TMO])) break; if (_sp > XB_SPIN_CAP) { atomicAdd(&(bar)[XB_TMO], 1u); break; } } } } while (0)
struct XcdBarrier { unsigned* bar; unsigned x; volatile LAS unsigned* st; };
DI XcdBarrier xcd_barrier_post(unsigned* bar, volatile LAS unsigned* st) {
    XcdBarrier b; b.bar = bar; b.x = xb_xcc_id(); b.st = st;
    if (threadIdx.x == 0) (void)xb_add(&bar[XB_XCNT(b.x)], 1u);
    return b;
}
DI void xcd_barrier_complete(unsigned* bar, unsigned x, unsigned& nloc, unsigned& nx) {
    const unsigned G = gridDim.x * gridDim.y * gridDim.z;
    unsigned sum, cnt, mine, sp = 0u;
    for (;;) {
        sum = 0u; cnt = 0u; mine = 0u;
#pragma unroll
        for (unsigned j = 0; j < 16; ++j) { const unsigned c = xb_ld(&bar[XB_XCNT(j)]); sum += c; cnt += (c > 0u) ? 1u : 0u; mine = (j == x) ? c : mine; }
        if (sum == G) break;
        __builtin_amdgcn_s_sleep(1);
        if ((++sp & 255u) == 0u) { if (xb_ld(&bar[XB_TMO])) break; if (sp > XB_SPIN_CAP) { atomicAdd(&bar[XB_TMO], 1u); break; } }
    }
    nloc = mine > 0u ? mine : 1u; nx = cnt > 0u ? cnt : 1u;
}
DI void xcd_barrier(const XcdBarrier& b) {
    asm volatile("s_waitcnt vmcnt(0)" ::: "memory");
    __syncthreads();
    if (threadIdx.x == 0) {
        unsigned* bar = b.bar;
        __builtin_amdgcn_s_waitcnt(0);
        unsigned nloc = b.st[0], nx = b.st[1];
        if (nloc == 0u) { xcd_barrier_complete(bar, b.x, nloc, nx); b.st[0] = nloc; b.st[1] = nx; }
        const unsigned old = xb_add(&bar[XB_XSUB(b.x)], 1u);
        const unsigned gen = old / nloc;
        if (old + 1u == (gen + 1u) * nloc) {
            __builtin_amdgcn_fence(__ATOMIC_RELEASE, "agent");
            asm volatile("s_waitcnt vmcnt(0)" ::: "memory");
            const unsigned og = xb_add(&bar[XB_TOP], 1u);
            const unsigned tg = og / nx;
            if (og + 1u == (tg + 1u) * nx) xb_add(&bar[XB_TOPGEN], 1u);
            else XB_SPIN(xb_ld(&bar[XB_TOPGEN]) == tg, bar);
            __builtin_amdgcn_fence(__ATOMIC_ACQUIRE, "agent");
            xb_add(&bar[XB_XGEN(b.x)], 1u);
            asm volatile("s_waitcnt vmcnt(0)" ::: "memory");
        } else {
            XB_SPIN(xb_ld(&bar[XB_XGEN(b.x)]) == gen, bar);
            __builtin_amdgcn_fence(__ATOMIC_ACQUIRE, "agent");
            asm volatile("s_waitcnt vmcnt(0)" ::: "memory");
        }
    }
    __syncthreads();
}
constexpr int LDS_BARST_OFF = 131072 + 64;

#define LPTR(i, stride) (ap->in[i] + (size_t)layer * (size_t)(stride))
#define xout (ap->out)
#define xin ((layer == 0) ? ap->in[0] : ap->out)
#define g_mix LPTR(1, DM)
#define w_in LPTR(2, DM * DIN)
#define g_cq LPTR(3, 384)
#define g_ckv LPTR(4, 256)
#define w_uq LPTR(5, 384 * 768)
#define w_ukv LPTR(6, 256 * 1024)
#define g_q_mla LPTR(7, 96)
#define g_k_mla LPTR(8, 96)
#define w_o_mla LPTR(9, 512 * 1024)
#define b_glu LPTR(10, 1024)
#define w_dw LPTR(11, 31 * 512)
#define b_dw LPTR(12, 512)
#define g_ln LPTR(13, 512)
#define b_ln LPTR(14, 512)
#define w_conv_out LPTR(15, 512 * 1024)
#define b_conv_out LPTR(16, 1024)
#define pe_k LPTR(17, 2048)
#define pe_v LPTR(18, 2048)
#define w_ck1 LPTR(19, 2048 * 128)
#define w_ck2 LPTR(20, 128 * 64)
#define w_cv1 LPTR(21, 2048 * 128)
#define w_cv2 LPTR(22, 128 * 64)
#define g_q_nsa LPTR(23, 64)
#define g_k_nsa LPTR(24, 64)
#define w_o_nsa LPTR(25, 512 * 1024)
#define w_out LPTR(26, 1024 * 1024)
#define g_ffn LPTR(27, DM)
#define w_ff1 LPTR(28, 1024 * 4096)
#define w_ff2 LPTR(29, 4096 * 1024)
#define Z ((bf16*)(ws + WS_Z))
#define HB ((bf16*)(ws + WS_HB))
#define Qa ((bf16*)(ws + WS_QA))
#define Ka ((bf16*)(ws + WS_KA))
#define Va ((bf16*)(ws + WS_VA))
#define H2 ((bf16*)(ws + WS_H2))
#define U ((bf16*)(ws + WS_U))
#define Acmp ((bf16*)(ws + WS_OA))
#define On ((bf16*)(ws + WS_ON))
#define H1 ((bf16*)(ws + WS_H1))
#define KC ((bf16*)(ws + WS_KC))
#define VC ((bf16*)(ws + WS_VC))
#define HDN ((bf16*)(ws + WS_Z))
#define SS1 ((float*)(ws + WS_SS1))
#define SS2 ((float*)(ws + WS_SS2))
#define wt_in ((bf16*)(ws + WT_IN))
#define wt_g ((bf16*)(ws + WT_G))
#define wt_uq ((bf16*)(ws + WT_UQ))
#define wt_ukv ((bf16*)(ws + WT_UKV))
#define wt_omla ((bf16*)(ws + WT_OMLA))
#define wt_conv ((bf16*)(ws + WT_CONV))
#define wt_onsa ((bf16*)(ws + WT_ONSA))
#define wt_out3 ((bf16*)(ws + WT_OUT3))
#define wt_ff1 ((bf16*)(ws + WT_FF1))
#define wt_ff2 ((bf16*)(ws + WT_FF2))
#define wt_cmp ((bf16*)(ws + WT_CMP))

__global__ void __launch_bounds__(NTHR, 2) hybrid_fwd(Args args) {
    extern __shared__ __attribute__((aligned(16))) unsigned char lds_raw[];
    LAS unsigned char* lds = (LAS unsigned char*)lds_raw;
    LAS char* ldc = (LAS char*)lds_raw;
    cg::grid_group grid = cg::this_grid();
    volatile LAS unsigned* barst = (volatile LAS unsigned*)(lds + LDS_BARST_OFF);
    if (threadIdx.x < 2) barst[threadIdx.x] = 0u;
    __syncthreads();
    XcdBarrier xbar = xcd_barrier_post((unsigned*)args.ws, barst);
    grid.sync();
#define GRID_BAR() do { xbar.bar = (unsigned*)((const __attribute__((address_space(4))) Args*)__builtin_amdgcn_kernarg_segment_ptr())->ws; xcd_barrier(xbar); } while (0)
    int tid, lane, wave, G, bid, gw, NGW, layer;
    unsigned char* ws;
    const __attribute__((address_space(4))) Args* ap;
#define PHASE_BEGIN() do { ap = (const __attribute__((address_space(4))) Args*)__builtin_amdgcn_kernarg_segment_ptr(); asm volatile("" : "+s"(ap)); \
        ws = ap->ws; tid = threadIdx.x; asm volatile("" : "+v"(tid)); lane = tid & 63; wave = __builtin_amdgcn_readfirstlane(tid >> 6); \
        G = gridDim.x; bid = blockIdx.x; asm volatile("" : "+s"(G), "+s"(bid)); layer = layer_it; asm volatile("" : "+s"(layer)); gw = bid * NWAVES + wave; NGW = G * NWAVES; } while (0)

#pragma unroll 1
    for (int layer_it = 0; layer_it < DEPTH; ++layer_it) {
        PHASE_BEGIN();
        if (PH(0)) {
            LAS float* scr = (LAS float*)(lds + wave * 16384);
            constexpr int I_IN = 16 * 96, I_G = 16 * 96, I_UQ = 6 * 24, I_UKV = 4 * 32, I_O = 8 * 32, I_OUT = 16 * 32, I_F1 = 16 * 128, I_F2 = 64 * 32, I_C = 32 * 4;
            constexpr int NITEMS = I_IN + I_G + I_UQ + I_UKV + 3 * I_O + I_OUT + I_F1 + I_F2 + 2 * I_C;
            for (int it = gw; it < NITEMS; it += NGW) {
                int r = it;
                if (r < I_IN) { tr_item(w_in, DIN, 0, 3000, wt_in, 1024, 0, 0, scr, r / 96, r % 96, lane, g_mix); continue; } r -= I_IN;
                if (r < I_G) { tr_item(w_in, DIN, C_GM, 3072, wt_g, 1024, 0, 0, scr, r / 96, r % 96, lane, g_mix); continue; } r -= I_G;
                if (r < I_UQ) { tr_item(w_uq, 768, 0, 768, wt_uq, 384, 0, 0, scr, r / 24, r % 24, lane); continue; } r -= I_UQ;
                if (r < I_UKV) { tr_item(w_ukv, 1024, 0, 1024, wt_ukv, 256, 0, 0, scr, r / 32, r % 32, lane); continue; } r -= I_UKV;
                if (r < I_O) { tr_item(w_o_mla, 1024, 0, 1024, wt_omla, 768, 0, 32 * (r / 32), scr, r / 32, r % 32, lane); continue; } r -= I_O;
                if (r < I_O) { tr_item(w_conv_out, 1024, 0, 1024, wt_conv, 512, 0, 0, scr, r / 32, r % 32, lane); continue; } r -= I_O;
                if (r < I_O) { tr_item(w_o_nsa, 1024, 0, 1024, wt_onsa, 512, 0, 0, scr, r / 32, r % 32, lane); continue; } r -= I_O;
                if (r < I_OUT) { tr_item(w_out, 1024, 0, 1024, wt_out3, 1024, 0, 0, scr, r / 32, r % 32, lane); continue; } r -= I_OUT;
                if (r < I_F1) { tr_item(w_ff1, 4096, 0, 4096, wt_ff1, 1024, 0, 0, scr, r / 128, r % 128, lane, g_ffn); continue; } r -= I_F1;
                if (r < I_F2) { tr_item(w_ff2, 1024, 0, 1024, wt_ff2, 4096, 0, 0, scr, r / 32, r % 32, lane); continue; } r -= I_F2;
                if (r < I_C) { tr_item(w_ck1, 128, 0, 128, wt_cmp, 2048, 0, 0, scr, r / 4, r % 4, lane); continue; } r -= I_C;
                tr_item(w_cv1, 128, 0, 128, wt_cmp, 2048, 128, 0, scr, r / 4, r % 4, lane);
            }
            for (int i = gw * 64 + lane; i < 1024 * 32; i += NGW * 64) { const int n = i >> 5, rem = i & 31; *(u32x4*)(wt_omla + (size_t)n * 768 + (rem >> 2) * 96 + 64 + (rem & 3) * 8) = (u32x4){0, 0, 0, 0}; }
            for (int i = bid * NTHR + tid; i < T; i += G * NTHR) ((unsigned long long*)SS2)[i] = 0ull;
            if (layer == 0) {
                for (int m = gw; m < T; m += NGW) { const float s = raw_row_1024(xin + (size_t)m * DM, HB + (size_t)m * DM, lane); if (lane == 0) ((unsigned long long*)SS1)[m] = (unsigned long long)(s * SS_FIX + 0.5f); }
                for (int gid = bid * NTHR + tid; gid < 4096 * 24; gid += G * NTHR) {
                    const int p = gid / 24, i = gid % 24;
                    const float inv = (i < 8) ? powf(THETA, -(float)i * (2.0f / 16.0f)) : powf(THETA, -(float)(i - 8) * (2.0f / 32.0f));
                    float sn, cs; sincosf((float)p * inv, &sn, &cs);
                    if (i < 8) { float* rt = (float*)(ws + WS_ROPE_N) + p * 16; rt[i] = cs; rt[8 + i] = sn; }
                    else { float* rt = (float*)(ws + WS_ROPE_M) + p * 32; rt[i - 8] = cs; rt[16 + i - 8] = sn; }
                }
            }
        }
        GRID_BAR();
        PHASE_BEGIN();

        run_gemm(lds, HB, 1024, wt_in, T, ZP, 1024, FScaleStore{Z, ZP, SS1});
        GRID_BAR();
        PHASE_BEGIN();

        if (PH(2)) {
#define R1_LOAD(S, m_) \
                u32x4* zc##S = (u32x4*)(Z + (size_t)(m_) * ZP); \
                const u32x4 cA0##S = zc##S[lane]; \
                const u32x4 cA1##S = (lane < 16) ? zc##S[64 + lane] : zero4; \
                const u32x4 cUa##S = zc##S[84 + lane], cUg##S = zc##S[148 + lane]; \
                const u32x4 cQ##S = zc##S[212 + lane]; \
                const u32x4 cK##S = (lane < 32) ? zc##S[kch] : zero4;
#define R1_COMPUTE(S, m_) do { \
                const int t = (m_) & (SEQ - 1); \
                const float* rtN = (const float*)(ws + WS_ROPE_N) + t * 16; \
                { \
                    float a0[8], a1[8]; unpack8(cA0##S, a0); unpack8(cA1##S, a1); \
                    const float s0 = ssq8(a0), s1 = ssq8(a1); \
                    const float ssq_q = wave_sum(lane < 48 ? s0 : 0.f), ssq_kv = wave_sum((lane >= 48 ? s0 : 0.f) + s1); \
                    const float rq = rsqrtf(ssq_q * (1.f / 384.f) + EPS), rkv = rsqrtf(ssq_kv * (1.f / 256.f) + EPS); \
                    float g[8]; load8f(lane < 48 ? g_cq + 8 * lane : g_ckv + 8 * (lane - 48), g); \
                    const float r0 = lane < 48 ? rq : rkv; \
                    _Pragma("unroll") for (int e = 0; e < 8; ++e) a0[e] = a0[e] * r0 * g[e]; \
                    zc##S[lane] = pack8(a0); \
                    if (lane < 16) { \
                        load8f(g_ckv + 8 * (16 + lane), g); \
                        _Pragma("unroll") for (int e = 0; e < 8; ++e) a1[e] = a1[e] * rkv * g[e]; \
                        zc##S[64 + lane] = pack8(a1); \
                    } \
                } \
                { \
                    float a[8], gt[8], ba[8], bg[8]; unpack8(cUa##S, a); unpack8(cUg##S, gt); load8f(b_glu + 8 * lane, ba); load8f(b_glu + 512 + 8 * lane, bg); \
                    _Pragma("unroll") for (int e = 0; e < 8; ++e) a[e] = (a[e] + ba[e]) * sigmoidf_(gt[e] + bg[e]); \
                    zc##S[84 + lane] = pack8(a); \
                } \
                zc##S[212 + lane] = nsa_head_chunk(cQ##S, g_q_nsa, rtN, lane, SC_NSA); \
                { \
                    const u32x4 kn = nsa_head_chunk(cK##S, g_k_nsa, rtN, lane); \
                    if (lane < 32) zc##S[kch] = kn; \
                } \
            } while (0)
            {
                const u32x4 zero4 = (u32x4){0, 0, 0, 0};
                const int kch = (lane < 16) ? 308 + lane : 340 + (lane - 16);
                int m = gw;
                for (; m + NGW < T; m += 2 * NGW) {
                    R1_LOAD(A, m) R1_LOAD(B, m + NGW)
                    R1_COMPUTE(A, m); R1_COMPUTE(B, m + NGW);
                }
                if (m < T) { R1_LOAD(A, m) R1_COMPUTE(A, m); }
            }
#undef R1_LOAD
#undef R1_COMPUTE
            for (int rI = gw; rI < 8192; rI += NGW) {
                const int which = rI >> 12, rr = rI & 4095;
                bf16* arow = Acmp + (size_t)rI * 2048;
                if (rr >= 4080) {
#pragma unroll
                    for (int it = 0; it < 4; ++it) *(u32x4*)(arow + (it * 64 + lane) * 8) = (u32x4){0, 0, 0, 0};
                    continue;
                }
                const int b = rr / 510, rem = rr % 510, c = rem >> 1, g = rem & 1;
                const float* pe = which ? pe_v : pe_k;
#pragma unroll
                for (int it = 0; it < 4; ++it) {
                    const int l = it * 8 + (lane >> 3), d0 = (lane & 7) * 8;
                    const u32x4 sv = *(const u32x4*)(Z + (size_t)(b * SEQ + 16 * c + l) * ZP + C_KVN + which * 128 + g * 64 + d0);
                    const f32x4 p0 = *(const f32x4*)(pe + l * 64 + d0), p1 = *(const f32x4*)(pe + l * 64 + d0 + 4);
                    u32x4 w; w.x = pk2(bflo(sv.x) + p0[0], bfhi(sv.x) + p0[1]); w.y = pk2(bflo(sv.y) + p0[2], bfhi(sv.y) + p0[3]);
                    w.z = pk2(bflo(sv.z) + p1[0], bfhi(sv.z) + p1[1]); w.w = pk2(bflo(sv.w) + p1[2], bfhi(sv.w) + p1[3]);
                    *(u32x4*)(arow + l * 64 + d0) = w;
                }
            }
        }
        GRID_BAR();
        PHASE_BEGIN();

        if (G >= 64) {
            if (bid < 32) { run_gemm_sub(lds, Acmp, 2048, wt_cmp, 8192, 256, 2048, FSilu{H1, 256}, 32, bid); }
            else { run_gemm_sub(lds, Z + C_CQ, ZP, wt_uq, T, 768, 384, FStoreBf16{Qa, 768}, G - 32, bid - 32);
                   run_gemm_sub(lds, Z + C_CKV, ZP, wt_ukv, T, 1024, 256, FStoreKV{Ka, Va}, G - 32, bid - 32); }
        } else {
            run_gemm(lds, Z + C_CQ, ZP, wt_uq, T, 768, 384, FStoreBf16{Qa, 768});
            run_gemm(lds, Z + C_CKV, ZP, wt_ukv, T, 1024, 256, FStoreKV{Ka, Va});
            run_gemm(lds, Acmp, 2048, wt_cmp, 8192, 256, 2048, FSilu{H1, 256});
        }
        GRID_BAR();
        PHASE_BEGIN();

        if (PH(6)) {
#define R2_LOAD(S, m_) \
                u32x4* qc##S = (u32x4*)(Qa + (size_t)(m_) * 768); u32x4* kc##S = (u32x4*)(Ka + (size_t)(m_) * 768); const u32x4* zc##S = (const u32x4*)(Z + (size_t)(m_) * ZP); \
                const u32x4 q0##S = act ? qc##S[hq * 12 + sub] : zero4, q1##S = act ? qc##S[(4 + hq) * 12 + sub] : zero4; \
                const u32x4 kr##S = (sub < 4) ? zc##S[80 + sub] : zero4; \
                const u32x4 k0##S = (sub < 4) ? kr##S : (act ? kc##S[hq * 12 + sub] : zero4), k1##S = (sub < 4) ? kr##S : (act ? kc##S[(4 + hq) * 12 + sub] : zero4);
#define R2_COMPUTE(S, m_) do { \
                const int t = (m_) & (SEQ - 1); \
                const float* rtM = (const float*)(ws + WS_ROPE_M) + t * 32; \
                const u32x4 oq0 = mla_head_chunk(q0##S, g_q_mla, rtM, lane, SC_MLA), oq1 = mla_head_chunk(q1##S, g_q_mla, rtM, lane, SC_MLA); \
                const u32x4 ok0 = mla_head_chunk(k0##S, g_k_mla, rtM, lane), ok1 = mla_head_chunk(k1##S, g_k_mla, rtM, lane); \
                if (act) { qc##S[hq * 12 + sub] = oq0; qc##S[(4 + hq) * 12 + sub] = oq1; kc##S[hq * 12 + sub] = ok0; kc##S[(4 + hq) * 12 + sub] = ok1; } \
            } while (0)
            {
                const int sub = lane & 15, hq = lane >> 4; const bool act = sub < 12;
                const u32x4 zero4 = (u32x4){0, 0, 0, 0};
                int m = gw;
                for (; m + NGW < T; m += 2 * NGW) {
                    R2_LOAD(A, m) R2_LOAD(B, m + NGW)
                    R2_COMPUTE(A, m); R2_COMPUTE(B, m + NGW);
                }
                if (m < T) { R2_LOAD(A, m) R2_COMPUTE(A, m); }
            }
#undef R2_LOAD
#undef R2_COMPUTE
            {
                LAS float* w2k = (LAS float*)lds;
                LAS float* w2v = (LAS float*)(lds + 32768);
                LAS float* hs = (LAS float*)(lds + 65536) + wave * 256;
                __syncthreads();
                for (int i = tid; i < 2048; i += NTHR) { ((LAS f32x4*)w2k)[i] = ((const f32x4*)w_ck2)[i]; ((LAS f32x4*)w2v)[i] = ((const f32x4*)w_cv2)[i]; }
                __syncthreads();
                for (int it = gw; it < NB * 2 * 256; it += NGW) {
                    const int c = it & 255, g = (it >> 8) & 1, b = it >> 9;
                    bf16* kc = KC + (size_t)it * 64; bf16* vc = VC + (size_t)it * 64;
                    if (c == 255) { kc[lane] = 0; vc[lane] = 0; continue; }
                    const int rr = (b * 255 + c) * 2 + g;
                    const unsigned hkw = ((const unsigned*)(H1 + (size_t)rr * 256))[lane], hvw = ((const unsigned*)(H1 + (size_t)(4096 + rr) * 256 + 128))[lane];
                    hs[2 * lane] = bflo(hkw); hs[2 * lane + 1] = bfhi(hkw); hs[128 + 2 * lane] = bflo(hvw); hs[128 + 2 * lane + 1] = bfhi(hvw);
                    float ak = 0.f, av = 0.f;
#pragma unroll 4
                    for (int j4 = 0; j4 < 32; ++j4) {
                        const f32x4 hk4 = *(const LAS f32x4*)(hs + 4 * j4), hv4 = *(const LAS f32x4*)(hs + 128 + 4 * j4);
#pragma unroll
                        for (int e = 0; e < 4; ++e) { ak += hk4[e] * w2k[(4 * j4 + e) * 64 + lane]; av += hv4[e] * w2v[(4 * j4 + e) * 64 + lane]; }
                    }
                    float cs = 1.f, sn = 0.f;
                    if (lane < 16) { const float* rt = (const float*)(ws + WS_ROPE_N) + (16 * c + 31) * 16; cs = rt[lane & 7]; sn = rt[8 + (lane & 7)]; }
                    const float rs = rsqrtf(wave_sum(ak * ak) * (1.f / 64.f) + EPS);
                    float y = ak * rs * g_k_nsa[lane];
                    const float pr = __shfl_xor(y, 8);
                    if (lane < 8) y = y * cs - pr * sn; else if (lane < 16) y = y * cs + pr * sn;
                    kc[lane] = f2bf(y); vc[lane] = f2bf(av);
                }
            }
            {
                LAS bf16* us = (LAS bf16*)lds;
                LAS float* ys = (LAS float*)(lds + 65536);
                float wreg[31];
#pragma unroll
                for (int j = 0; j < 31; ++j) wreg[j] = w_dw[j * 512 + tid];
                const float bdw = b_dw[tid];
                const f32x4 g0 = *(const f32x4*)(g_ln + lane * 8), g1 = *(const f32x4*)(g_ln + lane * 8 + 4), bb0 = *(const f32x4*)(b_ln + lane * 8), bb1 = *(const f32x4*)(b_ln + lane * 8 + 4);
                for (int unit = bid; unit < T / 32; unit += G) {
                    const int b = unit >> 7, t0 = (unit & 127) * 32;
                    __syncthreads();
                    {
                        u32x4 cv[8];
#pragma unroll
                        for (int i = 0; i < 8; ++i) {
                            const int ch = tid + i * NTHR, rw = ch >> 6, cc = ch & 63, tt = t0 - 30 + rw;
                            cv[i] = (u32x4){0, 0, 0, 0};
                            if (ch < 62 * 64 && tt >= 0) cv[i] = *(const u32x4*)(Z + (size_t)(b * SEQ + tt) * ZP + C_U + cc * 8);
                        }
#pragma unroll
                        for (int i = 0; i < 8; ++i) {
                            const int ch = tid + i * NTHR, rw = ch >> 6, cc = ch & 63;
                            if (ch < 62 * 64) *(LAS u32x4*)(us + rw * 512 + cc * 8) = cv[i];
                        }
                    }
                    __syncthreads();
                    {
                        float win[62];
#pragma unroll
                        for (int i = 0; i < 62; ++i) win[i] = bf2f(us[i * 512 + tid]);
#pragma unroll
                        for (int tt = 0; tt < 32; ++tt) {
                            float acc = bdw;
#pragma unroll
                            for (int j = 0; j < 31; ++j) acc += wreg[j] * win[tt + j];
                            ys[tt * 512 + tid] = acc;
                        }
                    }
                    __syncthreads();
#pragma unroll 1
                    for (int q = 0; q < 4; ++q) {
                        const int tt = wave * 4 + q;
                        const f32x4 a0 = *(const LAS f32x4*)(ys + tt * 512 + lane * 8), a1 = *(const LAS f32x4*)(ys + tt * 512 + lane * 8 + 4);
                        const float mean = wave_sum((a0[0] + a0[1]) + (a0[2] + a0[3]) + (a1[0] + a1[1]) + (a1[2] + a1[3])) * (1.f / 512.f);
                        const f32x4 d0 = a0 - mean, d1 = a1 - mean;
                        const float var = wave_sum((d0[0] * d0[0] + d0[1] * d0[1]) + (d0[2] * d0[2] + d0[3] * d0[3]) + (d1[0] * d1[0] + d1[1] * d1[1]) + (d1[2] * d1[2] + d1[3] * d1[3])) * (1.f / 512.f);
                        const float rs = rsqrtf(var + EPS);
                        f32x4 y0 = d0 * rs * g0 + bb0, y1 = d1 * rs * g1 + bb1;
#pragma unroll
                        for (int i = 0; i < 4; ++i) { y0[i] = y0[i] * sigmoidf_(y0[i]); y1[i] = y1[i] * sigmoidf_(y1[i]); }
                        u32x4 w; w.x = pk2(y0[0], y0[1]); w.y = pk2(y0[2], y0[3]); w.z = pk2(y1[0], y1[1]); w.w = pk2(y1[2], y1[3]);
                        *(u32x4*)(U + (size_t)(b * SEQ + t0 + tt) * 512 + lane * 8) = w;
                    }
                }
                __syncthreads();
            }
        }
        GRID_BAR();
        PHASE_BEGIN();

        if (PH(7)) {
            if (G == 256) {
                const int grp = bid >> 6, bh = bid & 63;
#pragma unroll 1
                for (int rd = 0; rd < 4; ++rd) {
                    const int qb = (rd == 0) ? 15 - grp : (rd == 1) ? 8 + grp : (rd == 2) ? 7 - grp : grp;
                    __syncthreads();
                    mla_unit(ldc, bh >> 3, bh & 7, qb, Qa, Ka, Va, tid, lane, wave);
                }
            } else {
                for (int u = bid; u < 1024; u += G) { __syncthreads(); mla_unit(ldc, (u & 63) >> 3, u & 7, 15 - (u >> 6), Qa, Ka, Va, tid, lane, wave); }
            }
            __syncthreads();
            for (int i = 0; ; ++i) {
                const int L = i * G + bid; if (L >= 1024) break;
                const int rnd = L / 16, bg = L % 16;
                const int ri = rnd >> 4, rk = rnd & 15;
                const int qb = 63 - 16 * ri - ((ri & 1) ? 15 - rk : rk);
                nsa_unit(ldc, bg >> 1, bg & 1, qb, Z, KC, VC, On, tid, lane, wave);
            }
        }
        GRID_BAR();
        PHASE_BEGIN();

        if (PH(8)) run_gemm(lds, Qa, 768, wt_omla, T, 1024, 768, FStoreBias{Z, ZP, 0, nullptr});
        if (PH(8)) run_gemm(lds, U, 512, wt_conv, T, 1024, 512, FStoreBias{Z, ZP, 1024, b_conv_out});
        if (PH(8)) run_gemm(lds, On, 512, wt_onsa, T, 1024, 512, FStoreBias{Z, ZP, 2048, nullptr});
        GRID_BAR();
        PHASE_BEGIN();

        run_gemm_triple(lds, HB, 1024, wt_g, T, ZP, 1024, EpiGate{Z, ZP, SS1});
        GRID_BAR();
        PHASE_BEGIN();

        for (int i = bid * NTHR + tid; i < T; i += G * NTHR) ((unsigned long long*)SS1)[i] = 0ull;
        run_gemm_epi(lds, Z, ZP, wt_out3, T, 1024, 1024, EpiResidStats{HB, H2, nullptr, SS2});
        GRID_BAR();
        PHASE_BEGIN();

        run_gemm(lds, H2, 1024, wt_ff1, T, 4096, 1024, FRelu2S{HDN, 4096, SS2});
        GRID_BAR();
        PHASE_BEGIN();

        run_gemm_epi(lds, HDN, 4096, wt_ff2, T, 1024, 4096, EpiResidStats{H2, HB, (layer == DEPTH - 1) ? xout : (float*)nullptr, SS1});
        GRID_BAR();
        PHASE_BEGIN();
    }
}

extern "C" void kernel_launch(void* const* d_in, const int* in_sizes, int n_in, void* d_out, int out_size, void* d_ws, size_t ws_size, hipStream_t stream) {
    static int grid = 0;
    if (grid == 0) {
        if (n_in != 30 || out_size != T * DM || ws_size < WS_END) { fprintf(stderr, "kernel_launch: unexpected shapes (n_in %d out %d ws %zu)\n", n_in, out_size, ws_size); grid = -1; return; }
        int dev = 0, cus = 0, per_cu = 0;
        hipGetDevice(&dev);
        hipDeviceGetAttribute(&cus, hipDeviceAttributeMultiprocessorCount, dev);
        hipFuncSetAttribute((const void*)hybrid_fwd, hipFuncAttributeMaxDynamicSharedMemorySize, LDS_BYTES);
        hipOccupancyMaxActiveBlocksPerMultiprocessor(&per_cu, (const void*)hybrid_fwd, NTHR, LDS_BYTES);
        if (per_cu < 1) per_cu = 1;
        grid = cus * per_cu;
        (void)hipGetLastError();
    }
    if (grid < 0) return;
    Args a{};
    for (int i = 0; i < 30; ++i) a.in[i] = (const float*)d_in[i];
    a.out = (float*)d_out; a.ws = (unsigned char*)d_ws;
    (void)hipMemsetAsync(d_ws, 0, 16384, stream);
    void* kargs[] = {&a};
    hipError_t e = hipLaunchCooperativeKernel((const void*)hybrid_fwd, dim3(grid), dim3(NTHR), kargs, LDS_BYTES, stream);
    if (e != hipSuccess) fprintf(stderr, "cooperative launch failed: %s (grid %d)\n", hipGetErrorString(e), grid);
}
```

```cpp
#include <hip/hip_runtime.h>
#include <hip/hip_cooperative_groups.h>
#include <cstdio>
#include <cstdint>
namespace cg = cooperative_groups;

#define DI __device__ __forceinline__
#define LAS __attribute__((address_space(3)))
typedef unsigned short bf16;
typedef short bf16x8 __attribute__((ext_vector_type(8)));
typedef short s16x4 __attribute__((ext_vector_type(4)));
typedef float f32x4 __attribute__((ext_vector_type(4)));
typedef float f32x16 __attribute__((ext_vector_type(16)));
typedef unsigned u32x4 __attribute__((ext_vector_type(4)));
typedef unsigned u32x2 __attribute__((ext_vector_type(2)));
typedef float f32x2_t __attribute__((ext_vector_type(2)));
typedef __bf16 bf16x2_t __attribute__((ext_vector_type(2)));

DI unsigned pk2(float lo, float hi) { f32x2_t v = {lo, hi}; bf16x2_t b = __builtin_convertvector(v, bf16x2_t); return __builtin_bit_cast(unsigned, b); }
DI float bflo(unsigned w) { return __uint_as_float(w << 16); }
DI float bfhi(unsigned w) { return __uint_as_float(w & 0xffff0000u); }
DI float bf2f(bf16 b) { return __uint_as_float(((unsigned)b) << 16); }
DI bf16 f2bf(float f) { return (bf16)(pk2(f, 0.f) & 0xffffu); }
DI float wave_sum(float v) {
#pragma unroll
    for (int o = 1; o < 64; o <<= 1) v += __shfl_xor(v, o);
    return v;
}
DI float sigmoidf_(float x) { return 1.0f / (1.0f + __expf(-x)); }
DI void unpack8(const u32x4 w, float (&f)[8]) { f[0] = bflo(w.x); f[1] = bfhi(w.x); f[2] = bflo(w.y); f[3] = bfhi(w.y); f[4] = bflo(w.z); f[5] = bfhi(w.z); f[6] = bflo(w.w); f[7] = bfhi(w.w); }
DI u32x4 pack8(const float (&f)[8]) { u32x4 w; w.x = pk2(f[0], f[1]); w.y = pk2(f[2], f[3]); w.z = pk2(f[4], f[5]); w.w = pk2(f[6], f[7]); return w; }
DI void load8f(const float* p, float (&f)[8]) { const f32x4 a = *(const f32x4*)p, b = *(const f32x4*)(p + 4); f[0] = a[0]; f[1] = a[1]; f[2] = a[2]; f[3] = a[3]; f[4] = b[0]; f[5] = b[1]; f[6] = b[2]; f[7] = b[3]; }

namespace pg8 {
#define PG8_LAS __attribute__((address_space(3)))
typedef unsigned short bf16_t;
constexpr int BM = 256, BK = 64, HALF = 128, HTB = HALF * BK * 2, STAGE_BYTES = 8 * HTB, NXCD = 8, WGM = 8;

__host__ __device__ __forceinline__ int lds_byte(int r, int c) { const int st = (r >> 4) * 2 + (c >> 5), rr = r & 15, cc = c & 31, ob = rr * 64 + cc * 2; return st * 1024 + (ob ^ (((ob >> 9) & 1) << 5)); }
__host__ __device__ __forceinline__ void stage_rc(int b, int& R, int& C) { const int st = b / 1024, sb = b % 1024, swz = sb ^ (((sb >> 9) & 1) << 5); R = (st >> 1) * 16 + swz / 64; C = (st & 1) * 32 + (swz % 64) / 2; }
__host__ __device__ __forceinline__ int perm32(int rho) { const int n = rho >> 4, i = rho & 15; return 8 * (i >> 2) + 4 * n + (i & 3); }

struct Unit { int pm, pn; };
struct Gemm { const bf16_t* A; const bf16_t* Bt; int M, N, K, lda; };

struct StaticOrder {
    int nM, nN, nwg, G, c;
    __device__ void init(int M, int N, int G_, int c_) { nM = M / BM; nN = N / BM; nwg = nM * nN; G = G_; c = c_; }
    __device__ bool next(int i, Unit& u) const {
        const long L = (long)i * G + c; if (L >= nwg) return false;
        int wgid = (int)L; { const int q = nwg / NXCD, r = nwg % NXCD, xcd = wgid % NXCD, off = wgid / NXCD; wgid = (xcd < r ? xcd * (q + 1) : r * (q + 1) + (xcd - r) * q) + off; }
        const int nig = WGM * nN, gid = wgid / nig, fm = gid * WGM, gsz = (nM - fm) < WGM ? (nM - fm) : WGM;
        u.pm = fm + ((wgid % nig) % gsz); u.pn = (wgid % nig) / gsz; return true;
    }
};

struct TripleOrder {
    StaticOrder so;
    __device__ void init(int M, int G_, int c_) { so.init(M, 1024, G_, c_); }
    __device__ bool next(int i, Unit& u) const { Unit s; if (!so.next(i / 3, s)) return false; u.pm = s.pm; u.pn = (i % 3) * 4 + s.pn; return true; }
};

template <class F> struct EpiF {
    static constexpr bool PERM = true;
    F f;
    __device__ __forceinline__ void operator()(const f32x4 (&acc)[2][2][4][2], const Unit& u, int wr, int wc, int fr, int fq) const {
        const int row0 = u.pm * BM + wr * 64 + fr, col0 = u.pn * BM + wc * 32 + 8 * fq;
#pragma unroll
        for (int ai = 0; ai < 2; ++ai)
#pragma unroll
            for (int m = 0; m < 4; ++m) {
                const int row = row0 + ai * HALF + m * 16;
                const float rc = f.rowctx(row);
#pragma unroll
                for (int bj = 0; bj < 2; ++bj) f(row, col0 + bj * HALF, acc[ai][bj][m][0], acc[ai][bj][m][1], rc);
            }
    }
};

template <class Epi, class Sched>
__device__ __forceinline__ void gemm_phase(PG8_LAS unsigned char* lds, const Gemm g, const Sched& S, const Epi& E) {
    int tid_ = threadIdx.x; asm volatile("" : "+v"(tid_));
    const int tid = tid_, wid = __builtin_amdgcn_readfirstlane(tid >> 6), lane = tid & 63, wr = wid >> 2, wc = wid & 3, fr = lane & 15, fq = lane >> 4;
    int K_ = g.K, lda_ = g.lda; asm volatile("" : "+s"(K_), "+s"(lda_));
    const int K = K_, nt = K / BK, lda = lda_;
    unsigned voffA[2], voffB[2];
#pragma unroll
    for (int i = 0; i < 2; ++i) { int R, C; stage_rc(tid * 16 + i * 8192, R, C); const int Rb = Epi::PERM ? ((R & ~31) + perm32(R & 31)) : R;
        voffA[i] = (unsigned)(R * lda + C) * 2u; voffB[i] = (unsigned)(Rb * K + C) * 2u; }
    const size_t kstep = (size_t)(BK * 2);
    const size_t hstepA = (size_t)HALF * lda * 2, hstepB = (size_t)HALF * K * 2;
    const size_t tstepA = 2 * hstepA, tstepB = 2 * hstepB;
    const unsigned ldsw = (unsigned)wid * 1024u;
    const int aoff = lds_byte(wr * 64 + fr, fq * 8), boff = lds_byte(wc * 32 + fr, fq * 8);
#define PG8_SA(b, h) (((b) * 2 + (h)) * HTB)
#define PG8_SB(b, h) ((4 + (b) * 2 + (h)) * HTB)
#define PG8_STAGE(bufoff, gbase, voff) do { _Pragma("unroll") for (int _i = 0; _i < 2; ++_i) \
        __builtin_amdgcn_global_load_lds((const unsigned*)((const char*)(gbase) + (voff)[_i]), (PG8_LAS unsigned*)(lds + (bufoff) + ldsw + _i * 8192), 16, 0, 0); } while (0)
#define PG8_LDA(dst, b, h) do { _Pragma("unroll") for (int m = 0; m < 4; ++m) _Pragma("unroll") for (int k = 0; k < 2; ++k) dst[m][k] = *(const PG8_LAS bf16x8*)(lds + PG8_SA(b, h) + aoff + m * 2048 + k * 1024); } while (0)
#define PG8_LDB(dst, b, h) do { _Pragma("unroll") for (int n = 0; n < 2; ++n) _Pragma("unroll") for (int k = 0; k < 2; ++k) dst[n][k] = *(const PG8_LAS bf16x8*)(lds + PG8_SB(b, h) + boff + n * 2048 + k * 1024); } while (0)
#define PG8_MMA(ai, bj, At, Bt) do { __builtin_amdgcn_s_setprio(1); _Pragma("unroll") for (int m = 0; m < 4; ++m) _Pragma("unroll") for (int n = 0; n < 2; ++n) _Pragma("unroll") for (int k = 0; k < 2; ++k) \
        acc[ai][bj][m][n] = __builtin_amdgcn_mfma_f32_16x16x32_bf16(Bt[n][k], At[m][k], acc[ai][bj][m][n], 0, 0, 0); __builtin_amdgcn_s_setprio(0); } while (0)
#define PG8_WAIT_V(n) asm volatile("s_waitcnt vmcnt(" #n ")" ::: "memory")
#define PG8_WAIT_L(n) asm volatile("s_waitcnt lgkmcnt(" #n ")" ::: "memory")
#define PG8_BAR __builtin_amdgcn_s_barrier()
#define PG8_SCHED __builtin_amdgcn_sched_barrier(0)
    Unit cur, nxt; int ui = 0;
    if (!S.next(0, cur)) return;
    f32x4 acc[2][2][4][2];
#pragma unroll
    for (int a = 0; a < 2; ++a)
#pragma unroll
        for (int b = 0; b < 2; ++b)
#pragma unroll
            for (int m = 0; m < 4; ++m)
#pragma unroll
                for (int n = 0; n < 2; ++n) acc[a][b][m][n] = (f32x4){0.f, 0.f, 0.f, 0.f};
    bf16x8 At[4][2], B0[2][2], B1[2][2];
    const char* cA = (const char*)g.A + (size_t)cur.pm * tstepA; const char* cB = (const char*)g.Bt + (size_t)cur.pn * tstepB;
    PG8_STAGE(PG8_SB(0, 0), cB, voffB); PG8_STAGE(PG8_SB(0, 1), cB + hstepB, voffB); PG8_STAGE(PG8_SA(0, 0), cA, voffA); PG8_STAGE(PG8_SA(0, 1), cA + hstepA, voffA);
    if (wr == 1) PG8_BAR;
    PG8_WAIT_V(2); PG8_BAR;
    PG8_STAGE(PG8_SB(1, 0), cB + kstep, voffB); PG8_STAGE(PG8_SA(1, 0), cA + kstep, voffA); PG8_STAGE(PG8_SB(1, 1), cB + hstepB + kstep, voffB);
    PG8_WAIT_V(6); PG8_BAR;
    for (;;) {
        const bool has_next = S.next(ui + 1, nxt);
        const char* nA = has_next ? (const char*)g.A + (size_t)nxt.pm * tstepA : cA; const char* nB = has_next ? (const char*)g.Bt + (size_t)nxt.pn * tstepB : cB;
        for (int t = 0; t < nt; t += 2) {
            const bool last = (t == nt - 2);
            const char* a1 = cA + (size_t)(t + 1) * kstep;
            const char* a2 = last ? nA : cA + (size_t)(t + 2) * kstep; const char* b2 = last ? nB : cB + (size_t)(t + 2) * kstep;
            const char* a3 = a2 + kstep; const char* b3 = b2 + kstep;
            PG8_LDB(B0, 0, 0); PG8_LDB(B1, 0, 1); PG8_SCHED; PG8_LDA(At, 0, 0); PG8_STAGE(PG8_SA(1, 1), a1 + hstepA, voffA);
            PG8_WAIT_V(8); PG8_WAIT_L(0); PG8_BAR; PG8_MMA(0, 0, At, B0); PG8_MMA(0, 1, At, B1); PG8_BAR; PG8_SCHED;
            PG8_LDA(At, 0, 1); PG8_STAGE(PG8_SB(0, 0), b2, voffB); PG8_STAGE(PG8_SB(0, 1), b2 + hstepB, voffB); PG8_STAGE(PG8_SA(0, 0), a2, voffA);
            PG8_WAIT_V(8); PG8_WAIT_L(0); PG8_BAR; PG8_MMA(1, 0, At, B0); PG8_MMA(1, 1, At, B1); PG8_BAR; PG8_SCHED;
            PG8_LDB(B0, 1, 0); PG8_LDB(B1, 1, 1); PG8_SCHED; PG8_LDA(At, 1, 0); PG8_STAGE(PG8_SA(0, 1), a2 + hstepA, voffA);
            PG8_WAIT_V(8); PG8_WAIT_L(0); PG8_BAR; PG8_MMA(0, 0, At, B0); PG8_MMA(0, 1, At, B1); PG8_BAR; PG8_SCHED;
            PG8_LDA(At, 1, 1); PG8_STAGE(PG8_SB(1, 0), b3, voffB); PG8_STAGE(PG8_SB(1, 1), b3 + hstepB, voffB); PG8_STAGE(PG8_SA(1, 0), a3, voffA);
            PG8_WAIT_V(8); PG8_WAIT_L(0); PG8_BAR; PG8_MMA(1, 0, At, B0); PG8_MMA(1, 1, At, B1); PG8_BAR; PG8_SCHED;
        }
        if (wr == 0) PG8_BAR;
        E(acc, cur, wr, wc, fr, fq);
        if (!has_next) break;
#pragma unroll
        for (int a = 0; a < 2; ++a)
#pragma unroll
            for (int b = 0; b < 2; ++b)
#pragma unroll
                for (int m = 0; m < 4; ++m)
#pragma unroll
                    for (int n = 0; n < 2; ++n) acc[a][b][m][n] = (f32x4){0.f, 0.f, 0.f, 0.f};
        cur = nxt; cA = nA; cB = nB; ++ui;
        if (wr == 1) PG8_BAR;
    }
    PG8_WAIT_V(0);
    PG8_BAR;
#undef PG8_SA
#undef PG8_SB
#undef PG8_STAGE
#undef PG8_LDA
#undef PG8_LDB
#undef PG8_MMA
#undef PG8_WAIT_V
#undef PG8_WAIT_L
#undef PG8_BAR
#undef PG8_SCHED
}
}

constexpr int DM = 1024, NB = 8, SEQ = 4096, DEPTH = 4, T = NB * SEQ;
constexpr int DIN = 6072, ZP = 3072;
constexpr int C_CQ = 0, C_CKV = 384, C_KR = 640, C_U = 672, C_QN = 1696, C_KVN = 2208, C_GN = 2976, C_GM = 3000;
constexpr float EPS = 1e-6f, THETA = 500000.0f;
constexpr int NWAVES = 8, NTHR = 512;
constexpr float SC_NSA = 0.125f * 1.4426950408889634f, SC_MLA = 0.10206207261596577f * 1.4426950408889634f;

constexpr size_t MiB = 1u << 20;
constexpr size_t WS_SS1 = 1 * MiB, WS_SS2 = 1 * MiB + 256 * 1024;
constexpr size_t WS_WT = 2 * MiB;
constexpr size_t WT_IN = WS_WT, WT_G = WS_WT + 6 * MiB, WT_UQ = WS_WT + 12 * MiB, WT_UKV = WS_WT + 13 * MiB, WT_OMLA = WS_WT + 14 * MiB  ,
                 WT_CONV = WS_WT + 16 * MiB, WT_ONSA = WS_WT + 17 * MiB, WT_OUT3 = WS_WT + 18 * MiB, WT_FF1 = WS_WT + 20 * MiB, WT_FF2 = WS_WT + 28 * MiB, WT_CMP = WS_WT + 36 * MiB;
constexpr size_t WS_Z = 39 * MiB;
constexpr size_t WS_QA = 231 * MiB;
constexpr size_t WS_KA = 279 * MiB;
constexpr size_t WS_VA = 327 * MiB;
constexpr size_t WS_H2 = 295 * MiB;
constexpr size_t WS_U = 359 * MiB;
constexpr size_t WS_ON = 391 * MiB;
constexpr size_t WS_OA = WS_ON;
constexpr size_t WS_H1 = 423 * MiB;
constexpr size_t WS_KC = 427 * MiB;
constexpr size_t WS_VC = WS_KC + 512 * 1024;
constexpr size_t WS_HB = 428 * MiB;
constexpr size_t WS_END = 492 * MiB;

constexpr int LDS_BYTES = 147456;
#ifndef PHMASK
#define PHMASK 0xffffffff
#endif
#define PH(k) ((PHMASK >> (k)) & 1)

struct Args { const float* in[30]; float* out; unsigned char* ws; };

DI void tr_item(const float* W, int ldw, int c0, int nvalid, bf16* WT, int ldt, int row_off, int koff, LAS float* scr, int kb, int nb, int lane, const float* gain = nullptr) {
    const int k0 = 64 * kb, n0 = 32 * nb;
    const int n = n0 + (lane & 31);
    float wv[32];
#pragma unroll
    for (int i = 0; i < 32; ++i) { const int kk = 2 * i + (lane >> 5); wv[i] = (n < nvalid) ? W[(size_t)(k0 + kk) * ldw + c0 + n] : 0.f; }
#pragma unroll
    for (int i = 0; i < 32; ++i) { const int kk = 2 * i + (lane >> 5); const float gs = gain ? gain[k0 + kk] : 1.f; scr[kk * 33 + (lane & 31)] = wv[i] * gs; }
    asm volatile("s_waitcnt lgkmcnt(0)" ::: "memory");
    const int c = lane & 7;
#pragma unroll
    for (int j = 0; j < 4; ++j) { const int nn = (lane >> 3) + 8 * j; const LAS float* s = scr + (8 * c) * 33 + nn;
        u32x4 o; o.x = pk2(s[0 * 33], s[1 * 33]); o.y = pk2(s[2 * 33], s[3 * 33]); o.z = pk2(s[4 * 33], s[5 * 33]); o.w = pk2(s[6 * 33], s[7 * 33]);
        *(u32x4*)(WT + (size_t)(row_off + n0 + nn) * ldt + koff + k0 + 8 * c) = o; }
    asm volatile("s_waitcnt lgkmcnt(0)" ::: "memory");
}

DI void rms_row_1024(const float* xrow, const float* g, bf16* orow, int lane) {
    const f32x4* xr = (const f32x4*)xrow + lane; const f32x4* gr = (const f32x4*)g + lane;
    f32x4 v[4]; float s = 0.f;
#pragma unroll
    for (int j = 0; j < 4; ++j) { v[j] = xr[64 * j]; s += (v[j].x * v[j].x + v[j].y * v[j].y) + (v[j].z * v[j].z + v[j].w * v[j].w); }
    const float r = rsqrtf(wave_sum(s) * (1.f / 1024.f) + EPS);
    u32x2* o8 = (u32x2*)orow + lane;
#pragma unroll
    for (int j = 0; j < 4; ++j) { const f32x4 gg = gr[64 * j]; u32x2 w; w.x = pk2(v[j].x * r * gg.x, v[j].y * r * gg.y); w.y = pk2(v[j].z * r * gg.z, v[j].w * r * gg.w); o8[64 * j] = w; }
}

DI float raw_row_1024(const float* xrow, bf16* orow, int lane) {
    const f32x4* xr = (const f32x4*)xrow + lane;
    f32x4 v[4]; float s = 0.f;
#pragma unroll
    for (int j = 0; j < 4; ++j) { v[j] = xr[64 * j]; s += (v[j].x * v[j].x + v[j].y * v[j].y) + (v[j].z * v[j].z + v[j].w * v[j].w); }
    u32x2* o8 = (u32x2*)orow + lane;
    s = 0.f;
#pragma unroll
    for (int j = 0; j < 4; ++j) { u32x2 w; w.x = pk2(v[j].x, v[j].y); w.y = pk2(v[j].z, v[j].w); o8[64 * j] = w;
        const float q0 = bflo(w.x), q1 = bfhi(w.x), q2 = bflo(w.y), q3 = bfhi(w.y); s += (q0 * q0 + q1 * q1) + (q2 * q2 + q3 * q3); }
    return wave_sum(s);
}
DI void rope_cs(int pos, int i, int rot_dim, float& c, float& s) {
    const float inv = powf(THETA, -(float)i * (2.0f / (float)rot_dim));
    const float ang = (float)pos * inv;
    sincosf(ang, &s, &c);
}

constexpr size_t WS_ROPE_N = 64 * 1024;
constexpr size_t WS_ROPE_M = WS_ROPE_N + 4096 * 16 * 4;
DI float ssq8(const float (&f)[8]) { return ((f[0] * f[0] + f[1] * f[1]) + (f[2] * f[2] + f[3] * f[3])) + ((f[4] * f[4] + f[5] * f[5]) + (f[6] * f[6] + f[7] * f[7])); }
DI u32x4 nsa_head_chunk(const u32x4 w, const float* gain, const float* rt  , int lane, float oscale = 1.0f) {
    float q[8]; unpack8(w, q);
    float ss = ssq8(q); ss += __shfl_xor(ss, 1); ss += __shfl_xor(ss, 2); ss += __shfl_xor(ss, 4);
    const float r = rsqrtf(ss * (1.f / 64.f) + EPS) * oscale;
    const int sub = lane & 7;
    float g[8]; load8f(gain + 8 * sub, g);
    float y[8], p[8];
#pragma unroll
    for (int e = 0; e < 8; ++e) y[e] = q[e] * r * g[e];
#pragma unroll
    for (int e = 0; e < 8; ++e) p[e] = __shfl_xor(y[e], 1);
    if (sub < 2) {
        float c[8], s[8]; load8f(rt, c); load8f(rt + 8, s);
#pragma unroll
        for (int e = 0; e < 8; ++e) y[e] = (sub == 0) ? (y[e] * c[e] - p[e] * s[e]) : (y[e] * c[e] + p[e] * s[e]);
    }
    return pack8(y);
}
DI u32x4 mla_head_chunk(const u32x4 w, const float* gain, const float* rt  , int lane, float oscale = 1.0f) {
    const int sub = lane & 15;
    float q[8]; unpack8(w, q);
    float ss = ssq8(q); ss += __shfl_xor(ss, 1); ss += __shfl_xor(ss, 2); ss += __shfl_xor(ss, 4); ss += __shfl_xor(ss, 8);
    const float r = rsqrtf(ss * (1.f / 96.f) + EPS) * oscale;
    float g[8]; load8f(gain + 8 * (sub < 12 ? sub : 0), g);
    float y[8], p[8];
#pragma unroll
    for (int e = 0; e < 8; ++e) y[e] = q[e] * r * g[e];
#pragma unroll
    for (int e = 0; e < 8; ++e) p[e] = __shfl_xor(y[e], 2);
    if (sub < 4) {
        float c[8], s[8]; load8f(rt + 8 * (sub & 1), c); load8f(rt + 16 + 8 * (sub & 1), s);
#pragma unroll
        for (int e = 0; e < 8; ++e) y[e] = (sub < 2) ? (y[e] * c[e] - p[e] * s[e]) : (y[e] * c[e] + p[e] * s[e]);
    }
    return pack8(y);
}

#define MFMA32(a, b, c) __builtin_amdgcn_mfma_f32_32x32x16_bf16((a), (b), (c), 0, 0, 0)
DI int crow(int i, int h) { return (i & 3) + 8 * (i >> 2) + 4 * h; }
typedef short v4i16_t __attribute__((ext_vector_type(4)));
DI s16x4 vtr(const LAS char* p) { return __builtin_bit_cast(s16x4, __builtin_amdgcn_ds_read_tr16_b64_v4i16((LAS v4i16_t*)p)); }

constexpr int VP = 144;
constexpr int ATT_KSZ = 13312, ATT_VSZ = 9216;
constexpr int ATT_K_OFF = 0;
constexpr int ATT_V_OFF = 2 * ATT_KSZ;
constexpr int ATT_IMP_OFF = 49152;
constexpr int ATT_SEL_OFF = 49152 + 65536;
static_assert(ATT_V_OFF + 2 * ATT_VSZ <= ATT_IMP_OFF, "attention LDS map");

DI float fexp2(float x) { return __builtin_amdgcn_exp2f(x); }
DI float xhalf_max(float v) { auto rr = __builtin_amdgcn_permlane32_swap(__float_as_uint(v), __float_as_uint(v), false, false); return fmaxf(__uint_as_float(rr[0]), __uint_as_float(rr[1])); }
DI float xhalf_sum(float v) { auto rr = __builtin_amdgcn_permlane32_swap(__float_as_uint(v), __float_as_uint(v), false, false); return __uint_as_float(rr[0]) + __uint_as_float(rr[1]); }
DI void lds_barrier() { asm volatile("s_waitcnt lgkmcnt(0)" ::: "memory"); __builtin_amdgcn_s_barrier(); asm volatile("" ::: "memory"); }

template <int DQK, int MODE, class Mask>
DI void flash_pass(LAS char* lds, const bf16* Kg, size_t kpitch, const bf16* Vg, size_t vpitch, int tile_lo, int tile_hi, int wave_tile_hi,
                   const bf16x8 (&qf)[DQK / 16], float sc, const Mask& mask, float& m_run, float& l_run, f32x16 (&o)[2],
                   LAS float* imp_row  , int tid, int lane) {
    constexpr int NKS = DQK / 16, KP = DQK * 2 + 16, KCH = DQK / 8, NCH = 64 * KCH;
    const int r = lane & 31, h = lane >> 5;
    u32x4 kreg0, kreg1 = (u32x4){0, 0, 0, 0}, vreg = (u32x4){0, 0, 0, 0};
    const int krow0 = tid / KCH, kc0 = tid % KCH, krow1 = (tid + 512) / KCH, kc1 = (tid + 512) % KCH;
    const int vkey = tid >> 3, vc = tid & 7;
    float prev = 0.f; (void)prev;
    const float inv_l = (MODE == 2) ? l_run : 0.f; (void)inv_l;
    if (tile_lo >= tile_hi) return;
#define FP_GLOAD(jt) do { const size_t k0_ = (size_t)(jt) * 64; \
        kreg0 = *(const u32x4*)(Kg + (k0_ + krow0) * kpitch + kc0 * 8); \
        if (NCH > 512 && tid + 512 < NCH) kreg1 = *(const u32x4*)(Kg + (k0_ + krow1) * kpitch + kc1 * 8); \
        if (MODE != 1) vreg = *(const u32x4*)(Vg + (k0_ + vkey) * vpitch + vc * 8); } while (0)
#define FP_LSTORE(buf) do { LAS char* Kd_ = lds + ATT_K_OFF + (buf) * ATT_KSZ; LAS char* Vd_ = lds + ATT_V_OFF + (buf) * ATT_VSZ; \
        *(LAS u32x4*)(Kd_ + krow0 * KP + kc0 * 16) = kreg0; \
        if (NCH > 512 && tid + 512 < NCH) *(LAS u32x4*)(Kd_ + krow1 * KP + kc1 * 16) = kreg1; \
        if (MODE != 1) *(LAS u32x4*)(Vd_ + vkey * VP + vc * 16) = vreg; } while (0)
    FP_GLOAD(tile_lo);
    {
        u32x4 nk0 = (u32x4){0, 0, 0, 0}, nk1 = (u32x4){0, 0, 0, 0}, nv = (u32x4){0, 0, 0, 0};
        const bool two = tile_lo + 1 < tile_hi;
        if (two) { const size_t k0_ = (size_t)(tile_lo + 1) * 64;
            nk0 = *(const u32x4*)(Kg + (k0_ + krow0) * kpitch + kc0 * 8);
            if (NCH > 512 && tid + 512 < NCH) nk1 = *(const u32x4*)(Kg + (k0_ + krow1) * kpitch + kc1 * 8);
            if (MODE != 1) nv = *(const u32x4*)(Vg + (k0_ + vkey) * vpitch + vc * 8); }
        lds_barrier();
        FP_LSTORE(0);
        if (two) { kreg0 = nk0; kreg1 = nk1; vreg = nv; }
    }
    lds_barrier();
    float mref = 0.f; bool href = false;
    if (MODE == 2) { mref = m_run; href = true; }
    f32x16 negm16, ol;
#pragma unroll
    for (int i = 0; i < 16; ++i) { negm16[i] = -mref; ol[i] = 0.f; }
    const bf16x8 ones8 = (bf16x8){0x3f80, 0x3f80, 0x3f80, 0x3f80, 0x3f80, 0x3f80, 0x3f80, 0x3f80};
    for (int j = tile_lo; j < tile_hi; ++j) {
        const int cur = (j - tile_lo) & 1;
        if (j + 1 < tile_hi) FP_LSTORE(cur ^ 1);
        if (j + 2 < tile_hi) FP_GLOAD(j + 2);
        if (j < wave_tile_hi) {
            const LAS char* Ks = lds + ATT_K_OFF + cur * ATT_KSZ; const LAS char* Vs = lds + ATT_V_OFF + cur * ATT_VSZ;
            bf16x8 kf[2][NKS];
#pragma unroll
            for (int kb = 0; kb < 2; ++kb)
#pragma unroll
                for (int kk = 0; kk < NKS; ++kk) kf[kb][kk] = *(const LAS bf16x8*)(Ks + (32 * kb + r) * KP + (16 * kk + 8 * h) * 2);
            __builtin_amdgcn_sched_barrier(0);
            f32x16 s[2];
            asm volatile("v_mfma_f32_32x32x16_bf16 %0, %1, %2, %3" : "=&v"(s[0]) : "v"(kf[0][0]), "v"(qf[0]), "v"(negm16));
            asm volatile("v_mfma_f32_32x32x16_bf16 %0, %1, %2, %3" : "=&v"(s[1]) : "v"(kf[1][0]), "v"(qf[0]), "v"(negm16));
#pragma unroll
            for (int kk = 1; kk < NKS; ++kk) {
                s[0] = MFMA32(kf[0][kk], qf[kk], s[0]);
                s[1] = MFMA32(kf[1][kk], qf[kk], s[1]);
            }
            __builtin_amdgcn_sched_barrier(0);
            s16x4 vlo[2][2][2], vhi[2][2][2];
            if (MODE != 1) {
                const int q4 = (lane & 15) >> 2, p4 = lane & 3, blk = (lane >> 4) & 1;
                const LAS char* vb0 = Vs + (4 * h + q4) * VP + (16 * blk) * 2 + 8 * p4;
#pragma unroll
                for (int kb = 0; kb < 2; ++kb)
#pragma unroll
                    for (int s2 = 0; s2 < 2; ++s2)
#pragma unroll
                        for (int d = 0; d < 2; ++d) { const LAS char* vb = vb0 + (32 * kb + 16 * s2) * VP + (32 * d) * 2; vlo[kb][s2][d] = vtr(vb); vhi[kb][s2][d] = vtr(vb + 8 * VP); }
            }
            __builtin_amdgcn_sched_barrier(0);
            const int key0 = j * 64 + 4 * h;
            if (mask.needs(j)) {
#pragma unroll
                for (int kb = 0; kb < 2; ++kb)
#pragma unroll
                    for (int i = 0; i < 16; ++i) { const int key = key0 + 32 * kb + (i & 3) + 8 * (i >> 2); s[kb][i] = mask(key, j) ? s[kb][i] : -3e30f; }
            }
            const bool on = mask.lane_on(j);
            if (MODE == 0 || MODE == 1) {
                asm volatile("s_nop 15\n\ts_nop 7" : "+v"(s[0]), "+v"(s[1]));
                float mt, mu;
                asm volatile("v_max3_f32 %0, %1, %2, %3" : "=v"(mt) : "v"(s[0][0]), "v"(s[0][1]), "v"(s[0][2]));
                asm volatile("v_max3_f32 %0, %1, %2, %3" : "=v"(mu) : "v"(s[1][0]), "v"(s[1][1]), "v"(s[1][2]));
#pragma unroll
                for (int i = 3; i < 15; i += 2) {
                    asm volatile("v_max3_f32 %0, %1, %2, %3" : "=v"(mt) : "v"(mt), "v"(s[0][i]), "v"(s[0][i + 1]));
                    asm volatile("v_max3_f32 %0, %1, %2, %3" : "=v"(mu) : "v"(mu), "v"(s[1][i]), "v"(s[1][i + 1]));
                }
                asm volatile("v_max3_f32 %0, %1, %2, %3" : "=v"(mt) : "v"(mt), "v"(s[0][15]), "v"(s[1][15]));
                asm volatile("v_max_f32 %0, %1, %2" : "=v"(mt) : "v"(mt), "v"(mu));
                mt = on ? mt : -3e30f;
                mt = xhalf_max(mt);
                const bool need = (mt > 8.0f) || (!href && mt > -1e29f);
                if (__builtin_amdgcn_ballot_w64(need) != 0ull) {
                    const float dl = need ? mt : 0.f;
                    const float alpha = href ? fexp2(-dl) : 0.f;
                    mref += dl; href = href || need;
#pragma unroll
                    for (int kb = 0; kb < 2; ++kb)
#pragma unroll
                        for (int i = 0; i < 16; ++i) s[kb][i] -= dl;
#pragma unroll
                    for (int i = 0; i < 16; ++i) { negm16[i] = -mref; ol[i] *= alpha; }
                    if (MODE == 0) {
#pragma unroll
                        for (int d = 0; d < 2; ++d)
#pragma unroll
                            for (int i = 0; i < 16; ++i) o[d][i] *= alpha;
                    }
                }
#pragma unroll
                for (int kb = 0; kb < 2; ++kb)
#pragma unroll
                    for (int i = 0; i < 16; ++i) s[kb][i] = fexp2(s[kb][i]);
            } else {
#pragma unroll
                for (int kb = 0; kb < 2; ++kb) {
#pragma unroll
                    for (int i = 0; i < 16; ++i) s[kb][i] = fexp2(s[kb][i]) * inv_l;
#pragma unroll
                    for (int ig = 0; ig < 4; ++ig) {
                        const float g4 = (s[kb][4 * ig] + s[kb][4 * ig + 1]) + (s[kb][4 * ig + 2] + s[kb][4 * ig + 3]);
                        const float pa = __shfl_xor(s[kb][4 * ig + 3], 32);
                        const float extra = h ? pa : prev;
                        prev = pa;
                        imp_row[16 * j + 8 * kb + 2 * ig + h] = g4 + extra;
                    }
                }
            }
#pragma unroll
            for (int kb = 0; kb < 2; ++kb)
#pragma unroll
                for (int s2 = 0; s2 < 2; ++s2) {
                    u32x4 pw; pw.x = pk2(s[kb][8 * s2 + 0], s[kb][8 * s2 + 1]); pw.y = pk2(s[kb][8 * s2 + 2], s[kb][8 * s2 + 3]);
                    pw.z = pk2(s[kb][8 * s2 + 4], s[kb][8 * s2 + 5]); pw.w = pk2(s[kb][8 * s2 + 6], s[kb][8 * s2 + 7]);
                    if (Mask::HAS_OFF) { const unsigned om = on ? 0xffffffffu : 0u; pw.x &= om; pw.y &= om; pw.z &= om; pw.w &= om; }
                    const bf16x8 pf = __builtin_bit_cast(bf16x8, pw);
                    if (MODE != 2) ol = MFMA32(ones8, pf, ol);
                    if (MODE != 1) {
#pragma unroll
                        for (int d = 0; d < 2; ++d) {
                            const s16x4 lo = vlo[kb][s2][d], hi = vhi[kb][s2][d];
                            const bf16x8 a = (bf16x8){lo[0], lo[1], lo[2], lo[3], hi[0], hi[1], hi[2], hi[3]};
                            o[d] = MFMA32(a, pf, o[d]);
                        }
                    }
                }
        }
        lds_barrier();
    }
    if (MODE != 2) { m_run = href ? mref : -1e29f; l_run = ol[0]; }
#undef FP_GLOAD
#undef FP_LSTORE
}

struct MaskCausal { static constexpr bool HAS_OFF = false; int t, q0w; DI bool operator()(int key, int) const { return key <= t; } DI bool needs(int j) const { return 64 * j + 63 > q0w; } DI bool lane_on(int) const { return true; } };
struct MaskCmp { static constexpr bool HAS_OFF = false; int t; DI bool operator()(int key, int) const { return 16 * key + 31 <= t; } DI bool needs(int) const { return true; } DI bool lane_on(int) const { return true; } };
struct MaskSlc { static constexpr bool HAS_OFF = true; int t, qb; unsigned long long sel; DI bool operator()(int key, int) const { return key <= t; } DI bool needs(int j) const { return j == qb; } DI bool lane_on(int j) const { return (sel >> j) & 1ull; } };
struct MaskWin { static constexpr bool HAS_OFF = false; int t, qb; DI bool operator()(int key, int) const { return key <= t && key > t - 512; } DI bool needs(int j) const { return j == qb || j == qb - 8; } DI bool lane_on(int) const { return true; } };

DI f32x16 zero16() { return (f32x16){0.f, 0.f, 0.f, 0.f, 0.f, 0.f, 0.f, 0.f, 0.f, 0.f, 0.f, 0.f, 0.f, 0.f, 0.f, 0.f}; }

DI void mla_unit(LAS char* lds, int b, int hd, int qb, bf16* Qa, const bf16* Ka, const bf16* Va, int tid, int lane, int wave) {
    const int r = lane & 31, h = lane >> 5;
    const size_t m0 = (size_t)b * SEQ;
    const int q0 = qb * 256 + wave * 32;
    const int t = q0 + r;
    bf16x8 qf[6];
#pragma unroll
    for (int kk = 0; kk < 6; ++kk) qf[kk] = *(const bf16x8*)(Qa + (m0 + t) * 768 + hd * 96 + 16 * kk + 8 * h);
    float m_run = -1e29f, l_run = 0.f; f32x16 o[2]; o[0] = zero16(); o[1] = zero16();
    const float sc = 0.10206207261596577f * 1.4426950408889634f;
    MaskCausal mk{t, q0};
    flash_pass<96, 0>(lds, Ka + m0 * 768 + hd * 96, 768, Va + m0 * 512 + hd * 64, 512, 0, 4 * qb + 4, (q0 + 31) / 64 + 1, qf, sc, mk, m_run, l_run, o, (LAS float*)nullptr, tid, lane);
    const float il = 1.0f / l_run;
    bf16* orow = Qa + (m0 + t) * 768 + hd * 96;
#pragma unroll
    for (int d = 0; d < 2; ++d)
#pragma unroll
        for (int ig = 0; ig < 4; ++ig) {
            u32x2 w; w.x = pk2(o[d][4 * ig] * il, o[d][4 * ig + 1] * il); w.y = pk2(o[d][4 * ig + 2] * il, o[d][4 * ig + 3] * il);
            *(u32x2*)(orow + 32 * d + 8 * ig + 4 * h) = w;
        }
}

DI void nsa_unit(LAS char* lds, int b, int g, int qb, const bf16* Z, const bf16* KC, const bf16* VC, bf16* On, int tid, int lane, int wave) {
    const int r = lane & 31, h = lane >> 5;
    const size_t m0 = (size_t)b * SEQ;
    const int hd = g * 4 + (wave >> 1), hl = wave >> 1, qloc = (wave & 1) * 32 + r;
    const int t = qb * 64 + qloc;
    const bf16* zrow = Z + (m0 + t) * ZP;
    bf16x8 qf[4];
#pragma unroll
    for (int kk = 0; kk < 4; ++kk) qf[kk] = *(const bf16x8*)(zrow + C_QN + hd * 64 + 16 * kk + 8 * h);
    const float g0 = sigmoidf_(bf2f(zrow[C_GN + hd * 3 + 0])), g1 = sigmoidf_(bf2f(zrow[C_GN + hd * 3 + 1])), g2 = sigmoidf_(bf2f(zrow[C_GN + hd * 3 + 2]));
    const float sc = 0.125f * 1.4426950408889634f;
    LAS float* stash = (LAS float*)(lds + ATT_IMP_OFF) + wave * 2048 + lane;
    f32x16 o[2];
    LAS float* impH = (LAS float*)(lds + ATT_IMP_OFF);
    LAS unsigned long long* selm = (LAS unsigned long long*)(lds + ATT_SEL_OFF);
    {
        const bf16* Kc = KC + (size_t)(b * 2 + g) * 256 * 64; const bf16* Vc = VC + (size_t)(b * 2 + g) * 256 * 64;
        const int cmax = (qb * 64 + 32) / 16;
        const int ntile = cmax / 64 + 1;
        MaskCmp mk{t};
        float m_run = -1e29f, l_run = 0.f; o[0] = zero16(); o[1] = zero16();
        flash_pass<64, 1>(lds, Kc, 64, Vc, 64, 0, ntile, ntile, qf, sc, mk, m_run, l_run, o, (LAS float*)nullptr, tid, lane);
        float il = (l_run > 0.f && m_run > -1e28f) ? 1.0f / l_run : 0.f;
        float mfix = (m_run > -1e28f) ? m_run : 0.f;
        flash_pass<64, 2>(lds, Kc, 64, Vc, 64, 0, ntile, ntile, qf, sc, mk, mfix, il, o, impH + (hl * 64 + qloc) * 64, tid, lane);
    }
    __syncthreads();
    {
        const int n = lane;
#pragma unroll 1
        for (int qi = 0; qi < 8; ++qi) {
            const int q = wave * 8 + qi;
            float v = -INFINITY;
            if (n <= qb) {
                v = ((impH[(0 * 64 + q) * 64 + n] + impH[(1 * 64 + q) * 64 + n]) + impH[(2 * 64 + q) * 64 + n]) + impH[(3 * 64 + q) * 64 + n];
                if (n == 0 || n == qb || n == qb - 1) v = 1e6f;
            }
            LAS float* vs = (LAS float*)(lds + ATT_SEL_OFF + 512) + wave * 64;
            vs[n] = v;
            int cnt = 0;
#pragma unroll 4
            for (int m4 = 0; m4 < 16; ++m4) {
                const f32x4 vm = *(const LAS f32x4*)(vs + 4 * m4);
#pragma unroll
                for (int e = 0; e < 4; ++e) { const int m = 4 * m4 + e; cnt += (vm[e] > v || (vm[e] == v && m < n)) ? 1 : 0; }
            }
            const bool sel = (cnt < 16) && (n <= qb);
            const unsigned long long mk = __ballot(sel);
            if (lane == 0) selm[q] = mk;
        }
    }
    __syncthreads();
#pragma unroll
    for (int d = 0; d < 2; ++d)
#pragma unroll
        for (int i = 0; i < 16; ++i) stash[(d * 16 + i) * 64] = g0 * o[d][i];
    {
        const unsigned long long sel = selm[qloc];
        MaskSlc mk{t, qb, sel};
        float m_run = -1e29f, l_run = 0.f; o[0] = zero16(); o[1] = zero16();
        const bf16* Kg = Z + m0 * ZP + C_KVN + 2 * 128 + g * 64; const bf16* Vg = Z + m0 * ZP + C_KVN + 3 * 128 + g * 64;
        flash_pass<64, 0>(lds, Kg, ZP, Vg, ZP, 0, qb + 1, qb + 1, qf, sc, mk, m_run, l_run, o, (LAS float*)nullptr, tid, lane);
        const float w = g1 / l_run;
#pragma unroll
        for (int d = 0; d < 2; ++d)
#pragma unroll
            for (int i = 0; i < 16; ++i) stash[(d * 16 + i) * 64] += w * o[d][i];
    }
    {
        MaskWin mk{t, qb};
        float m_run = -1e29f, l_run = 0.f; o[0] = zero16(); o[1] = zero16();
        const bf16* Kg = Z + m0 * ZP + C_KVN + 4 * 128 + g * 64; const bf16* Vg = Z + m0 * ZP + C_KVN + 5 * 128 + g * 64;
        const int lo = qb - 8 > 0 ? qb - 8 : 0;
        flash_pass<64, 0>(lds, Kg, ZP, Vg, ZP, lo, qb + 1, qb + 1, qf, sc, mk, m_run, l_run, o, (LAS float*)nullptr, tid, lane);
        const float w = g2 / l_run;
#pragma unroll
        for (int d = 0; d < 2; ++d)
#pragma unroll
            for (int i = 0; i < 16; ++i) o[d][i] = stash[(d * 16 + i) * 64] + w * o[d][i];
    }
    bf16* orow = On + (m0 + t) * 512 + hd * 64;
#pragma unroll
    for (int d = 0; d < 2; ++d)
#pragma unroll
        for (int ig = 0; ig < 4; ++ig) {
            u32x2 w; w.x = pk2(o[d][4 * ig], o[d][4 * ig + 1]); w.y = pk2(o[d][4 * ig + 2], o[d][4 * ig + 3]);
            *(u32x2*)(orow + 32 * d + 8 * ig + 4 * h) = w;
        }
    __syncthreads();
}

constexpr float SS_FIX = 16777216.0f;
DI float rscale(const float* ss, int row) { const unsigned long long v = ((const unsigned long long*)ss)[row]; return rsqrtf((float)v * (1.0f / SS_FIX) * (1.f / 1024.f) + EPS); }

struct FStoreBf16 { bf16* O; int ldc;
    DI float rowctx(int) const { return 1.f; }
    DI void operator()(int row, int col, f32x4 a, f32x4 b, float rc) const { u32x4 w; w.x = pk2(a[0], a[1]); w.y = pk2(a[2], a[3]); w.z = pk2(b[0], b[1]); w.w = pk2(b[2], b[3]); *(u32x4*)(O + (size_t)row * ldc + col) = w; } };
struct FStoreKV { bf16* Ka; bf16* Va;
    DI float rowctx(int) const { return 1.f; }
    DI void operator()(int row, int col, f32x4 a, f32x4 b, float rc) const { u32x4 w; w.x = pk2(a[0], a[1]); w.y = pk2(a[2], a[3]); w.z = pk2(b[0], b[1]); w.w = pk2(b[2], b[3]);
        const int hd = col >> 7, c = col & 127;
        if (c < 64) *(u32x4*)(Ka + (size_t)row * 768 + hd * 96 + 32 + c) = w; else *(u32x4*)(Va + (size_t)row * 512 + hd * 64 + (c - 64)) = w; } };
struct FSilu { bf16* O; int ldc;
    DI float rowctx(int) const { return 1.f; }
    DI void operator()(int row, int col, f32x4 a, f32x4 b, float rc) const {
#pragma unroll
        for (int i = 0; i < 4; ++i) { a[i] = a[i] * sigmoidf_(a[i]); b[i] = b[i] * sigmoidf_(b[i]); }
        u32x4 w; w.x = pk2(a[0], a[1]); w.y = pk2(a[2], a[3]); w.z = pk2(b[0], b[1]); w.w = pk2(b[2], b[3]); *(u32x4*)(O + (size_t)row * ldc + col) = w; } };
struct FStoreBias { bf16* O; int ldc; int coloff; const float* bias;
    DI float rowctx(int) const { return 1.f; }
    DI void operator()(int row, int col, f32x4 a, f32x4 b, float rc) const {
        if (bias) { const f32x4 b0 = *(const f32x4*)(bias + col), b1 = *(const f32x4*)(bias + col + 4); a += b0; b += b1; }
        u32x4 w; w.x = pk2(a[0], a[1]); w.y = pk2(a[2], a[3]); w.z = pk2(b[0], b[1]); w.w = pk2(b[2], b[3]); *(u32x4*)(O + (size_t)row * ldc + coloff + col) = w; } };
struct FGateMul { bf16* P; int ldc; const float* ss;
    DI float rowctx(int row) const { return rscale(ss, row); }
    DI void operator()(int row, int col, f32x4 a, f32x4 b, float rc) const {
        const int mix = col >> 10, c = col & 1023;
        a *= rc; b *= rc;
        const u32x4 ov = *(const u32x4*)(P + (size_t)row * ldc + col);
        float o[8]; unpack8(ov, o);
        float acc[8] = {0.f, 0.f, 0.f, 0.f, 0.f, 0.f, 0.f, 0.f};
        u32x4* slot = (u32x4*)(P + (size_t)row * ldc + c);
        if (mix) { const u32x4 sv = *slot; unpack8(sv, acc); }
        acc[0] += sigmoidf_(a[0]) * o[0]; acc[1] += sigmoidf_(a[1]) * o[1]; acc[2] += sigmoidf_(a[2]) * o[2]; acc[3] += sigmoidf_(a[3]) * o[3];
        acc[4] += sigmoidf_(b[0]) * o[4]; acc[5] += sigmoidf_(b[1]) * o[5]; acc[6] += sigmoidf_(b[2]) * o[6]; acc[7] += sigmoidf_(b[3]) * o[7];
        *slot = pack8(acc); } };
struct EpiGate {
    static constexpr bool PERM = true;
    bf16* P; int ldc; const float* ss;
    __device__ __forceinline__ void operator()(const f32x4 (&acc)[2][2][4][2], const pg8::Unit& u, int wr, int wc, int fr, int fq) const {
        const int row0 = u.pm * pg8::BM + wr * 64 + fr, col0 = u.pn * pg8::BM + wc * 32 + 8 * fq;
        const int mix = u.pn >> 2;
#pragma unroll
        for (int ai = 0; ai < 2; ++ai) {
            u32x4 ov[4][2], sv[4][2]; float rc[4];
#pragma unroll
            for (int m = 0; m < 4; ++m) {
                const int row = row0 + ai * pg8::HALF + m * 16;
#pragma unroll
                for (int bj = 0; bj < 2; ++bj) {
                    const int col = col0 + bj * pg8::HALF;
                    ov[m][bj] = *(const u32x4*)(P + (size_t)row * ldc + col);
                    sv[m][bj] = (u32x4){0, 0, 0, 0};
                    if (mix) sv[m][bj] = *(const u32x4*)(P + (size_t)row * ldc + (col & 1023));
                }
                rc[m] = rscale(ss, row);
            }
#pragma unroll
            for (int m = 0; m < 4; ++m) {
                const int row = row0 + ai * pg8::HALF + m * 16;
#pragma unroll
                for (int bj = 0; bj < 2; ++bj) {
                    const int col = col0 + bj * pg8::HALF;
                    const f32x4 a = acc[ai][bj][m][0] * rc[m], b = acc[ai][bj][m][1] * rc[m];
                    float o[8], s[8]; unpack8(ov[m][bj], o); unpack8(sv[m][bj], s);
                    s[0] += sigmoidf_(a[0]) * o[0]; s[1] += sigmoidf_(a[1]) * o[1]; s[2] += sigmoidf_(a[2]) * o[2]; s[3] += sigmoidf_(a[3]) * o[3];
                    s[4] += sigmoidf_(b[0]) * o[4]; s[5] += sigmoidf_(b[1]) * o[5]; s[6] += sigmoidf_(b[2]) * o[6]; s[7] += sigmoidf_(b[3]) * o[7];
                    *(u32x4*)(P + (size_t)row * ldc + (col & 1023)) = pack8(s);
                }
            }
        }
    }
};
struct FScaleStore { bf16* O; int ldc; const float* ss;
    DI float rowctx(int row) const { return rscale(ss, row); }
    DI void operator()(int row, int col, f32x4 a, f32x4 b, float rc) const { a *= rc; b *= rc;
        u32x4 w; w.x = pk2(a[0], a[1]); w.y = pk2(a[2], a[3]); w.z = pk2(b[0], b[1]); w.w = pk2(b[2], b[3]); *(u32x4*)(O + (size_t)row * ldc + col) = w; } };
struct FRelu2S { bf16* O; int ldc; const float* ss;
    DI float rowctx(int row) const { return rscale(ss, row); }
    DI void operator()(int row, int col, f32x4 a, f32x4 b, float rc) const {
#pragma unroll
        for (int i = 0; i < 4; ++i) { const float x = fmaxf(a[i] * rc, 0.f), y = fmaxf(b[i] * rc, 0.f); a[i] = x * x; b[i] = y * y; }
        u32x4 w; w.x = pk2(a[0], a[1]); w.y = pk2(a[2], a[3]); w.z = pk2(b[0], b[1]); w.w = pk2(b[2], b[3]); *(u32x4*)(O + (size_t)row * ldc + col) = w; } };
struct EpiResidStats {
    static constexpr bool PERM = true;
    const bf16* rin; bf16* rout; float* fout; float* ss;
    __device__ __forceinline__ void operator()(const f32x4 (&acc)[2][2][4][2], const pg8::Unit& u, int wr, int wc, int fr, int fq) const {
        const int row0 = u.pm * pg8::BM + wr * 64 + fr, col0 = u.pn * pg8::BM + wc * 32 + 8 * fq;
#pragma unroll
        for (int ai = 0; ai < 2; ++ai) {
            u32x4 rv[4][2];
#pragma unroll
            for (int m = 0; m < 4; ++m)
#pragma unroll
                for (int bj = 0; bj < 2; ++bj) rv[m][bj] = *(const u32x4*)(rin + (row0 + ai * pg8::HALF + m * 16) * DM + col0 + bj * pg8::HALF);
#pragma unroll
            for (int m = 0; m < 4; ++m) {
                const int row = row0 + ai * pg8::HALF + m * 16;
                float part = 0.f;
#pragma unroll
                for (int bj = 0; bj < 2; ++bj) {
                    const int off = row * DM + col0 + bj * pg8::HALF;
                    float xr[8]; unpack8(rv[m][bj], xr);
                    const f32x4 a0 = acc[ai][bj][m][0], a1 = acc[ai][bj][m][1];
                    float xn[8] = {xr[0] + a0[0], xr[1] + a0[1], xr[2] + a0[2], xr[3] + a0[3], xr[4] + a1[0], xr[5] + a1[1], xr[6] + a1[2], xr[7] + a1[3]};
                    if (fout) { *(f32x4*)(fout + off) = (f32x4){xn[0], xn[1], xn[2], xn[3]}; *(f32x4*)(fout + off + 4) = (f32x4){xn[4], xn[5], xn[6], xn[7]}; }
                    const u32x4 w = pack8(xn);
                    *(u32x4*)(rout + off) = w;
                    float xq[8]; unpack8(w, xq);
                    part += ssq8(xq);
                }
                part += __shfl_xor(part, 16); part += __shfl_xor(part, 32);
                if (fq == 0) atomicAdd((unsigned long long*)ss + row, (unsigned long long)(part * SS_FIX + 0.5f));
            }
        }
    }
};
struct FResid { const float* xin; float* out;
    DI float rowctx(int) const { return 1.f; }
    DI void operator()(int row, int col, f32x4 a, f32x4 b, float rc) const {
        const f32x4* xi = (const f32x4*)(xin + (size_t)row * DM + col); f32x4* xo = (f32x4*)(out + (size_t)row * DM + col);
        const f32x4 x0 = xi[0], x1 = xi[1]; xo[0] = x0 + a; xo[1] = x1 + b; } };
struct FRelu2 { bf16* O; int ldc;
    DI void operator()(int row, int col, f32x4 a, f32x4 b) const {
#pragma unroll
        for (int i = 0; i < 4; ++i) { const float x = fmaxf(a[i], 0.f), y = fmaxf(b[i], 0.f); a[i] = x * x; b[i] = y * y; }
        u32x4 w; w.x = pk2(a[0], a[1]); w.y = pk2(a[2], a[3]); w.z = pk2(b[0], b[1]); w.w = pk2(b[2], b[3]); *(u32x4*)(O + (size_t)row * ldc + col) = w; } };

template <class E>
DI void run_gemm_epi(LAS unsigned char* lds, const bf16* A, int lda, const bf16* Bt, int M, int N, int K, const E& e) {
    pg8::Gemm g{A, Bt, M, N, K, lda}; pg8::StaticOrder S; S.init(M, N, (int)gridDim.x, (int)blockIdx.x);
    pg8::gemm_phase<E, pg8::StaticOrder>(lds, g, S, e);
}
template <class F>
DI void run_gemm_sub(LAS unsigned char* lds, const bf16* A, int lda, const bf16* Bt, int M, int N, int K, const F& f, int Geff, int ceff) {
    pg8::Gemm g{A, Bt, M, N, K, lda}; pg8::StaticOrder S; S.init(M, N, Geff, ceff);
    pg8::EpiF<F> E{f};
    pg8::gemm_phase<pg8::EpiF<F>, pg8::StaticOrder>(lds, g, S, E);
}
template <class E>
DI void run_gemm_triple(LAS unsigned char* lds, const bf16* A, int lda, const bf16* Bt, int M, int N, int K, const E& e) {
    pg8::Gemm g{A, Bt, M, N, K, lda}; pg8::TripleOrder S; S.init(M, (int)gridDim.x, (int)blockIdx.x);
    pg8::gemm_phase<E, pg8::TripleOrder>(lds, g, S, e);
}
template <class F>
DI void run_gemm(LAS unsigned char* lds, const bf16* A, int lda, const bf16* Bt, int M, int N, int K, const F& f) {
    pg8::Gemm g{A, Bt, M, N, K, lda}; pg8::StaticOrder S; S.init(M, N, (int)gridDim.x, (int)blockIdx.x);
    pg8::EpiF<F> E{f};
    pg8::gemm_phase<pg8::EpiF<F>, pg8::StaticOrder>(lds, g, S, E);
}


#define XB_TMO      128
#define XB_XCNT(j)  (256  + 64 * (j))
#define XB_XSUB(j)  (1280 + 64 * (j))
#define XB_XGEN(j)  (2304 + 64 * (j))
#define XB_TOP      3328
#define XB_TOPGEN   3392
#define XCD_BAR_WORDS 3456
#define XB_SPIN_CAP (1u << 22)
DI unsigned xb_ld(unsigned* p)              { return __hip_atomic_load(p, __ATOMIC_RELAXED, __HIP_MEMORY_SCOPE_AGENT); }
DI unsigned xb_add(unsigned* p, unsigned v) { return __hip_atomic_fetch_add(p, v, __ATOMIC_RELAXED, __HIP_MEMORY_SCOPE_AGENT); }
DI unsigned xb_xcc_id() { return (unsigned)__builtin_amdgcn_s_getreg((3 << 11) | 20) & 0xFu; }
#define XB_SPIN(cond, bar) do { unsigned _sp = 0; while (cond) { __builtin_amdgcn_s_sleep(1); \
    if ((++_sp & 255u) == 0u) { if (xb_ld(&(bar)[XB_TMO])) break; if (_sp > XB_SPIN_CAP) { atomicAdd(&(bar)[XB_TMO], 1u); break; } } } } while (0)
struct XcdBarrier { unsigned* bar; unsigned x; volatile LAS unsigned* st; };
DI XcdBarrier xcd_barrier_post(unsigned* bar, volatile LAS unsigned* st) {
    XcdBarrier b; b.bar = bar; b.x = xb_xcc_id(); b.st = st;
    if (threadIdx.x == 0) (void)xb_add(&bar[XB_XCNT(b.x)], 1u);
    return b;
}
DI void xcd_barrier_complete(unsigned* bar, unsigned x, unsigned& nloc, unsigned& nx) {
    const unsigned G = gridDim.x * gridDim.y * gridDim.z;
    unsigned sum, cnt, mine, sp = 0u;
    for (;;) {
        sum = 0u; cnt = 0u; mine = 0u;
#pragma unroll
        for (unsigned j = 0; j < 16; ++j) { const unsigned c = xb_ld(&bar[XB_XCNT(j)]); sum += c; cnt += (c > 0u) ? 1u : 0u; mine = (j == x) ? c : mine; }
        if (sum == G) break;
        __builtin_amdgcn_s_sleep(1);
        if ((++sp & 255u) == 0u) { if (xb_ld(&bar[XB_TMO])) break; if (sp > XB_SPIN_CAP) { atomicAdd(&bar[XB_TMO], 1u); break; } }
    }
    nloc = mine > 0u ? mine : 1u; nx = cnt > 0u ? cnt : 1u;
}
DI void xcd_barrier(const XcdBarrier& b) {
    asm volatile("s_waitcnt vmcnt(0)" ::: "memory");
    __syncthreads();
    if (threadIdx.x == 0) {
        unsigned* bar = b.bar;
        __builtin_amdgcn_s_waitcnt(0);
        unsigned nloc = b.st[0], nx = b.st[1];
        if (nloc == 0u) { xcd_barrier_complete(bar, b.x, nloc, nx); b.st[0] = nloc; b.st[1] = nx; }
        const unsigned old = xb_add(&bar[XB_XSUB(b.x)], 1u);
        const unsigned gen = old / nloc;
        if (old + 1u == (gen + 1u) * nloc) {
            __builtin_amdgcn_fence(__ATOMIC_RELEASE, "agent");
            asm volatile("s_waitcnt vmcnt(0)" ::: "memory");
            const unsigned og = xb_add(&bar[XB_TOP], 1u);
            const unsigned tg = og / nx;
            if (og + 1u == (tg + 1u) * nx) xb_add(&bar[XB_TOPGEN], 1u);
            else XB_SPIN(xb_ld(&bar[XB_TOPGEN]) == tg, bar);
            __builtin_amdgcn_fence(__ATOMIC_ACQUIRE, "agent");
            xb_add(&bar[XB_XGEN(b.x)], 1u);
            asm volatile("s_waitcnt vmcnt(0)" ::: "memory");
        } else {
            XB_SPIN(xb_ld(&bar[XB_XGEN(b.x)]) == gen, bar);
            __builtin_amdgcn_fence(__ATOMIC_ACQUIRE, "agent");
            asm volatile("s_waitcnt vmcnt(0)" ::: "memory");
        }
    }
    __syncthreads();
}
constexpr int LDS_BARST_OFF = 131072 + 64;

#define LPTR(i, stride) (ap->in[i] + (size_t)layer * (size_t)(stride))
#define xout (ap->out)
#define xin ((layer == 0) ? ap->in[0] : ap->out)
#define g_mix LPTR(1, DM)
#define w_in LPTR(2, DM * DIN)
#define g_cq LPTR(3, 384)
#define g_ckv LPTR(4, 256)
#define w_uq LPTR(5, 384 * 768)
#define w_ukv LPTR(6, 256 * 1024)
#define g_q_mla LPTR(7, 96)
#define g_k_mla LPTR(8, 96)
#define w_o_mla LPTR(9, 512 * 1024)
#define b_glu LPTR(10, 1024)
#define w_dw LPTR(11, 31 * 512)
#define b_dw LPTR(12, 512)
#define g_ln LPTR(13, 512)
#define b_ln LPTR(14, 512)
#define w_conv_out LPTR(15, 512 * 1024)
#define b_conv_out LPTR(16, 1024)
#define pe_k LPTR(17, 2048)
#define pe_v LPTR(18, 2048)
#define w_ck1 LPTR(19, 2048 * 128)
#define w_ck2 LPTR(20, 128 * 64)
#define w_cv1 LPTR(21, 2048 * 128)
#define w_cv2 LPTR(22, 128 * 64)
#define g_q_nsa LPTR(23, 64)
#define g_k_nsa LPTR(24, 64)
#define w_o_nsa LPTR(25, 512 * 1024)
#define w_out LPTR(26, 1024 * 1024)
#define g_ffn LPTR(27, DM)
#define w_ff1 LPTR(28, 1024 * 4096)
#define w_ff2 LPTR(29, 4096 * 1024)
#define Z ((bf16*)(ws + WS_Z))
#define HB ((bf16*)(ws + WS_HB))
#define Qa ((bf16*)(ws + WS_QA))
#define Ka ((bf16*)(ws + WS_KA))
#define Va ((bf16*)(ws + WS_VA))
#define H2 ((bf16*)(ws + WS_H2))
#define U ((bf16*)(ws + WS_U))
#define Acmp ((bf16*)(ws + WS_OA))
#define On ((bf16*)(ws + WS_ON))
#define H1 ((bf16*)(ws + WS_H1))
#define KC ((bf16*)(ws + WS_KC))
#define VC ((bf16*)(ws + WS_VC))
#define HDN ((bf16*)(ws + WS_Z))
#define SS1 ((float*)(ws + WS_SS1))
#define SS2 ((float*)(ws + WS_SS2))
#define wt_in ((bf16*)(ws + WT_IN))
#define wt_g ((bf16*)(ws + WT_G))
#define wt_uq ((bf16*)(ws + WT_UQ))
#define wt_ukv ((bf16*)(ws + WT_UKV))
#define wt_omla ((bf16*)(ws + WT_OMLA))
#define wt_conv ((bf16*)(ws + WT_CONV))
#define wt_onsa ((bf16*)(ws + WT_ONSA))
#define wt_out3 ((bf16*)(ws + WT_OUT3))
#define wt_ff1 ((bf16*)(ws + WT_FF1))
#define wt_ff2 ((bf16*)(ws + WT_FF2))
#define wt_cmp ((bf16*)(ws + WT_CMP))

__global__ void __launch_bounds__(NTHR, 2) hybrid_fwd(Args args) {
    extern __shared__ __attribute__((aligned(16))) unsigned char lds_raw[];
    LAS unsigned char* lds = (LAS unsigned char*)lds_raw;
    LAS char* ldc = (LAS char*)lds_raw;
    cg::grid_group grid = cg::this_grid();
    volatile LAS unsigned* barst = (volatile LAS unsigned*)(lds + LDS_BARST_OFF);
    if (threadIdx.x < 2) barst[threadIdx.x] = 0u;
    __syncthreads();
    XcdBarrier xbar = xcd_barrier_post((unsigned*)args.ws, barst);
    grid.sync();
#define GRID_BAR() do { xbar.bar = (unsigned*)((const __attribute__((address_space(4))) Args*)__builtin_amdgcn_kernarg_segment_ptr())->ws; xcd_barrier(xbar); } while (0)
    int tid, lane, wave, G, bid, gw, NGW, layer;
    unsigned char* ws;
    const __attribute__((address_space(4))) Args* ap;
#define PHASE_BEGIN() do { ap = (const __attribute__((address_space(4))) Args*)__builtin_amdgcn_kernarg_segment_ptr(); asm volatile("" : "+s"(ap)); \
        ws = ap->ws; tid = threadIdx.x; asm volatile("" : "+v"(tid)); lane = tid & 63; wave = __builtin_amdgcn_readfirstlane(tid >> 6); \
        G = gridDim.x; bid = blockIdx.x; asm volatile("" : "+s"(G), "+s"(bid)); layer = layer_it; asm volatile("" : "+s"(layer)); gw = bid * NWAVES + wave; NGW = G * NWAVES; } while (0)

#pragma unroll 1
    for (int layer_it = 0; layer_it < DEPTH; ++layer_it) {
        PHASE_BEGIN();
        if (PH(0)) {
            LAS float* scr = (LAS float*)(lds + wave * 16384);
            constexpr int I_IN = 16 * 96, I_G = 16 * 96, I_UQ = 6 * 24, I_UKV = 4 * 32, I_O = 8 * 32, I_OUT = 16 * 32, I_F1 = 16 * 128, I_F2 = 64 * 32, I_C = 32 * 4;
            constexpr int NITEMS = I_IN + I_G + I_UQ + I_UKV + 3 * I_O + I_OUT + I_F1 + I_F2 + 2 * I_C;
            for (int it = gw; it < NITEMS; it += NGW) {
                int r = it;
                if (r < I_IN) { tr_item(w_in, DIN, 0, 3000, wt_in, 1024, 0, 0, scr, r / 96, r % 96, lane, g_mix); continue; } r -= I_IN;
                if (r < I_G) { tr_item(w_in, DIN, C_GM, 3072, wt_g, 1024, 0, 0, scr, r / 96, r % 96, lane, g_mix); continue; } r -= I_G;
                if (r < I_UQ) { tr_item(w_uq, 768, 0, 768, wt_uq, 384, 0, 0, scr, r / 24, r % 24, lane); continue; } r -= I_UQ;
                if (r < I_UKV) { tr_item(w_ukv, 1024, 0, 1024, wt_ukv, 256, 0, 0, scr, r / 32, r % 32, lane); continue; } r -= I_UKV;
                if (r < I_O) { tr_item(w_o_mla, 1024, 0, 1024, wt_omla, 768, 0, 32 * (r / 32), scr, r / 32, r % 32, lane); continue; } r -= I_O;
                if (r < I_O) { tr_item(w_conv_out, 1024, 0, 1024, wt_conv, 512, 0, 0, scr, r / 32, r % 32, lane); continue; } r -= I_O;
                if (r < I_O) { tr_item(w_o_nsa, 1024, 0, 1024, wt_onsa, 512, 0, 0, scr, r / 32, r % 32, lane); continue; } r -= I_O;
                if (r < I_OUT) { tr_item(w_out, 1024, 0, 1024, wt_out3, 1024, 0, 0, scr, r / 32, r % 32, lane); continue; } r -= I_OUT;
                if (r < I_F1) { tr_item(w_ff1, 4096, 0, 4096, wt_ff1, 1024, 0, 0, scr, r / 128, r % 128, lane, g_ffn); continue; } r -= I_F1;
                if (r < I_F2) { tr_item(w_ff2, 1024, 0, 1024, wt_ff2, 4096, 0, 0, scr, r / 32, r % 32, lane); continue; } r -= I_F2;
                if (r < I_C) { tr_item(w_ck1, 128, 0, 128, wt_cmp, 2048, 0, 0, scr, r / 4, r % 4, lane); continue; } r -= I_C;
                tr_item(w_cv1, 128, 0, 128, wt_cmp, 2048, 128, 0, scr, r / 4, r % 4, lane);
            }
            for (int i = gw * 64 + lane; i < 1024 * 32; i += NGW * 64) { const int n = i >> 5, rem = i & 31; *(u32x4*)(wt_omla + (size_t)n * 768 + (rem >> 2) * 96 + 64 + (rem & 3) * 8) = (u32x4){0, 0, 0, 0}; }
            for (int i = bid * NTHR + tid; i < T; i += G * NTHR) ((unsigned long long*)SS2)[i] = 0ull;
            if (layer == 0) {
                for (int m = gw; m < T; m += NGW) { const float s = raw_row_1024(xin + (size_t)m * DM, HB + (size_t)m * DM, lane); if (lane == 0) ((unsigned long long*)SS1)[m] = (unsigned long long)(s * SS_FIX + 0.5f); }
                for (int gid = bid * NTHR + tid; gid < 4096 * 24; gid += G * NTHR) {
                    const int p = gid / 24, i = gid % 24;
                    const float inv = (i < 8) ? powf(THETA, -(float)i * (2.0f / 16.0f)) : powf(THETA, -(float)(i - 8) * (2.0f / 32.0f));
                    float sn, cs; sincosf((float)p * inv, &sn, &cs);
                    if (i < 8) { float* rt = (float*)(ws + WS_ROPE_N) + p * 16; rt[i] = cs; rt[8 + i] = sn; }
                    else { float* rt = (float*)(ws + WS_ROPE_M) + p * 32; rt[i - 8] = cs; rt[16 + i - 8] = sn; }
                }
            }
        }
        GRID_BAR();
        PHASE_BEGIN();

        run_gemm(lds, HB, 1024, wt_in, T, ZP, 1024, FScaleStore{Z, ZP, SS1});
        GRID_BAR();
        PHASE_BEGIN();

        if (PH(2)) {
#define R1_LOAD(S, m_) \
                u32x4* zc##S = (u32x4*)(Z + (size_t)(m_) * ZP); \
                const u32x4 cA0##S = zc##S[lane]; \
                const u32x4 cA1##S = (lane < 16) ? zc##S[64 + lane] : zero4; \
                const u32x4 cUa##S = zc##S[84 + lane], cUg##S = zc##S[148 + lane]; \
                const u32x4 cQ##S = zc##S[212 + lane]; \
                const u32x4 cK##S = (lane < 32) ? zc##S[kch] : zero4;
#define R1_COMPUTE(S, m_) do { \
                const int t = (m_) & (SEQ - 1); \
                const float* rtN = (const float*)(ws + WS_ROPE_N) + t * 16; \
                { \
                    float a0[8], a1[8]; unpack8(cA0##S, a0); unpack8(cA1##S, a1); \
                    const float s0 = ssq8(a0), s1 = ssq8(a1); \
                    const float ssq_q = wave_sum(lane < 48 ? s0 : 0.f), ssq_kv = wave_sum((lane >= 48 ? s0 : 0.f) + s1); \
                    const float rq = rsqrtf(ssq_q * (1.f / 384.f) + EPS), rkv = rsqrtf(ssq_kv * (1.f / 256.f) + EPS); \
                    float g[8]; load8f(lane < 48 ? g_cq + 8 * lane : g_ckv + 8 * (lane - 48), g); \
                    const float r0 = lane < 48 ? rq : rkv; \
                    _Pragma("unroll") for (int e = 0; e < 8; ++e) a0[e] = a0[e] * r0 * g[e]; \
                    zc##S[lane] = pack8(a0); \
                    if (lane < 16) { \
                        load8f(g_ckv + 8 * (16 + lane), g); \
                        _Pragma("unroll") for (int e = 0; e < 8; ++e) a1[e] = a1[e] * rkv * g[e]; \
                        zc##S[64 + lane] = pack8(a1); \
                    } \
                } \
                { \
                    float a[8], gt[8], ba[8], bg[8]; unpack8(cUa##S, a); unpack8(cUg##S, gt); load8f(b_glu + 8 * lane, ba); load8f(b_glu + 512 + 8 * lane, bg); \
                    _Pragma("unroll") for (int e = 0; e < 8; ++e) a[e] = (a[e] + ba[e]) * sigmoidf_(gt[e] + bg[e]); \
                    zc##S[84 + lane] = pack8(a); \
                } \
                zc##S[212 + lane] = nsa_head_chunk(cQ##S, g_q_nsa, rtN, lane, SC_NSA); \
                { \
                    const u32x4 kn = nsa_head_chunk(cK##S, g_k_nsa, rtN, lane); \
                    if (lane < 32) zc##S[kch] = kn; \
                } \
            } while (0)
            {
                const u32x4 zero4 = (u32x4){0, 0, 0, 0};
                const int kch = (lane < 16) ? 308 + lane : 340 + (lane - 16);
                int m = gw;
                for (; m + NGW < T; m += 2 * NGW) {
                    R1_LOAD(A, m) R1_LOAD(B, m + NGW)
                    R1_COMPUTE(A, m); R1_COMPUTE(B, m + NGW);
                }
                if (m < T) { R1_LOAD(A, m) R1_COMPUTE(A, m); }
            }
#undef R1_LOAD
#undef R1_COMPUTE
            for (int rI = gw; rI < 8192; rI += NGW) {
                const int which = rI >> 12, rr = rI & 4095;
                bf16* arow = Acmp + (size_t)rI * 2048;
                if (rr >= 4080) {
#pragma unroll
                    for (int it = 0; it < 4; ++it) *(u32x4*)(arow + (it * 64 + lane) * 8) = (u32x4){0, 0, 0, 0};
                    continue;
                }
                const int b = rr / 510, rem = rr % 510, c = rem >> 1, g = rem & 1;
                const float* pe = which ? pe_v : pe_k;
#pragma unroll
                for (int it = 0; it < 4; ++it) {
                    const int l = it * 8 + (lane >> 3), d0 = (lane & 7) * 8;
                    const u32x4 sv = *(const u32x4*)(Z + (size_t)(b * SEQ + 16 * c + l) * ZP + C_KVN + which * 128 + g * 64 + d0);
                    const f32x4 p0 = *(const f32x4*)(pe + l * 64 + d0), p1 = *(const f32x4*)(pe + l * 64 + d0 + 4);
                    u32x4 w; w.x = pk2(bflo(sv.x) + p0[0], bfhi(sv.x) + p0[1]); w.y = pk2(bflo(sv.y) + p0[2], bfhi(sv.y) + p0[3]);
                    w.z = pk2(bflo(sv.z) + p1[0], bfhi(sv.z) + p1[1]); w.w = pk2(bflo(sv.w) + p1[2], bfhi(sv.w) + p1[3]);
                    *(u32x4*)(arow + l * 64 + d0) = w;
                }
            }
        }
        GRID_BAR();
        PHASE_BEGIN();

        if (G >= 64) {
            if (bid < 32) { run_gemm_sub(lds, Acmp, 2048, wt_cmp, 8192, 256, 2048, FSilu{H1, 256}, 32, bid); }
            else { run_gemm_sub(lds, Z + C_CQ, ZP, wt_uq, T, 768, 384, FStoreBf16{Qa, 768}, G - 32, bid - 32);
                   run_gemm_sub(lds, Z + C_CKV, ZP, wt_ukv, T, 1024, 256, FStoreKV{Ka, Va}, G - 32, bid - 32); }
        } else {
            run_gemm(lds, Z + C_CQ, ZP, wt_uq, T, 768, 384, FStoreBf16{Qa, 768});
            run_gemm(lds, Z + C_CKV, ZP, wt_ukv, T, 1024, 256, FStoreKV{Ka, Va});
            run_gemm(lds, Acmp, 2048, wt_cmp, 8192, 256, 2048, FSilu{H1, 256});
        }
        GRID_BAR();
        PHASE_BEGIN();

        if (PH(6)) {
#define R2_LOAD(S, m_) \
                u32x4* qc##S = (u32x4*)(Qa + (size_t)(m_) * 768); u32x4* kc##S = (u32x4*)(Ka + (size_t)(m_) * 768); const u32x4* zc##S = (const u32x4*)(Z + (size_t)(m_) * ZP); \
                const u32x4 q0##S = act ? qc##S[hq * 12 + sub] : zero4, q1##S = act ? qc##S[(4 + hq) * 12 + sub] : zero4; \
                const u32x4 kr##S = (sub < 4) ? zc##S[80 + sub] : zero4; \
                const u32x4 k0##S = (sub < 4) ? kr##S : (act ? kc##S[hq * 12 + sub] : zero4), k1##S = (sub < 4) ? kr##S : (act ? kc##S[(4 + hq) * 12 + sub] : zero4);
#define R2_COMPUTE(S, m_) do { \
                const int t = (m_) & (SEQ - 1); \
                const float* rtM = (const float*)(ws + WS_ROPE_M) + t * 32; \
                const u32x4 oq0 = mla_head_chunk(q0##S, g_q_mla, rtM, lane, SC_MLA), oq1 = mla_head_chunk(q1##S, g_q_mla, rtM, lane, SC_MLA); \
                const u32x4 ok0 = mla_head_chunk(k0##S, g_k_mla, rtM, lane), ok1 = mla_head_chunk(k1##S, g_k_mla, rtM, lane); \
                if (act) { qc##S[hq * 12 + sub] = oq0; qc##S[(4 + hq) * 12 + sub] = oq1; kc##S[hq * 12 + sub] = ok0; kc##S[(4 + hq) * 12 + sub] = ok1; } \
            } while (0)
            {
                const int sub = lane & 15, hq = lane >> 4; const bool act = sub < 12;
                const u32x4 zero4 = (u32x4){0, 0, 0, 0};
                int m = gw;
                for (; m + NGW < T; m += 2 * NGW) {
                    R2_LOAD(A, m) R2_LOAD(B, m + NGW)
                    R2_COMPUTE(A, m); R2_COMPUTE(B, m + NGW);
                }
                if (m < T) { R2_LOAD(A, m) R2_COMPUTE(A, m); }
            }
#undef R2_LOAD
#undef R2_COMPUTE
            {
                LAS float* w2k = (LAS float*)lds;
                LAS float* w2v = (LAS float*)(lds + 32768);
                LAS float* hs = (LAS float*)(lds + 65536) + wave * 256;
                __syncthreads();
                for (int i = tid; i < 2048; i += NTHR) { ((LAS f32x4*)w2k)[i] = ((const f32x4*)w_ck2)[i]; ((LAS f32x4*)w2v)[i] = ((const f32x4*)w_cv2)[i]; }
                __syncthreads();
                for (int it = gw; it < NB * 2 * 256; it += NGW) {
                    const int c = it & 255, g = (it >> 8) & 1, b = it >> 9;
                    bf16* kc = KC + (size_t)it * 64; bf16* vc = VC + (size_t)it * 64;
                    if (c == 255) { kc[lane] = 0; vc[lane] = 0; continue; }
                    const int rr = (b * 255 + c) * 2 + g;
                    const unsigned hkw = ((const unsigned*)(H1 + (size_t)rr * 256))[lane], hvw = ((const unsigned*)(H1 + (size_t)(4096 + rr) * 256 + 128))[lane];
                    hs[2 * lane] = bflo(hkw); hs[2 * lane + 1] = bfhi(hkw); hs[128 + 2 * lane] = bflo(hvw); hs[128 + 2 * lane + 1] = bfhi(hvw);
                    float ak = 0.f, av = 0.f;
#pragma unroll 4
                    for (int j4 = 0; j4 < 32; ++j4) {
                        const f32x4 hk4 = *(const LAS f32x4*)(hs + 4 * j4), hv4 = *(const LAS f32x4*)(hs + 128 + 4 * j4);
#pragma unroll
                        for (int e = 0; e < 4; ++e) { ak += hk4[e] * w2k[(4 * j4 + e) * 64 + lane]; av += hv4[e] * w2v[(4 * j4 + e) * 64 + lane]; }
                    }
                    float cs = 1.f, sn = 0.f;
                    if (lane < 16) { const float* rt = (const float*)(ws + WS_ROPE_N) + (16 * c + 31) * 16; cs = rt[lane & 7]; sn = rt[8 + (lane & 7)]; }
                    const float rs = rsqrtf(wave_sum(ak * ak) * (1.f / 64.f) + EPS);
                    float y = ak * rs * g_k_nsa[lane];
                    const float pr = __shfl_xor(y, 8);
                    if (lane < 8) y = y * cs - pr * sn; else if (lane < 16) y = y * cs + pr * sn;
                    kc[lane] = f2bf(y); vc[lane] = f2bf(av);
                }
            }
            {
                LAS bf16* us = (LAS bf16*)lds;
                LAS float* ys = (LAS float*)(lds + 65536);
                float wreg[31];
#pragma unroll
                for (int j = 0; j < 31; ++j) wreg[j] = w_dw[j * 512 + tid];
                const float bdw = b_dw[tid];
                for (int unit = bid; unit < T / 32; unit += G) {
                    const int b = unit >> 7, t0 = (unit & 127) * 32;
                    __syncthreads();
                    {
                        u32x4 cv[8];
#pragma unroll
                        for (int i = 0; i < 8; ++i) {
                            const int ch = tid + i * NTHR, rw = ch >> 6, cc = ch & 63, tt = t0 - 30 + rw;
                            cv[i] = (u32x4){0, 0, 0, 0};
                            if (ch < 62 * 64 && tt >= 0) cv[i] = *(const u32x4*)(Z + (size_t)(b * SEQ + tt) * ZP + C_U + cc * 8);
                        }
#pragma unroll
                        for (int i = 0; i < 8; ++i) {
                            const int ch = tid + i * NTHR, rw = ch >> 6, cc = ch & 63;
                            if (ch < 62 * 64) *(LAS u32x4*)(us + rw * 512 + cc * 8) = cv[i];
                        }
                    }
                    __syncthreads();
                    {
                        float win[62];
#pragma unroll
                        for (int i = 0; i < 62; ++i) win[i] = bf2f(us[i * 512 + tid]);
#pragma unroll
                        for (int tt = 0; tt < 32; ++tt) {
                            float acc = bdw;
#pragma unroll
                            for (int j = 0; j < 31; ++j) acc += wreg[j] * win[tt + j];
                            ys[tt * 512 + tid] = acc;
                        }
                    }
                    __syncthreads();
#pragma unroll 1
                    for (int q = 0; q < 4; ++q) {
                        const int tt = wave * 4 + q;
                        const f32x4 a0 = *(const LAS f32x4*)(ys + tt * 512 + lane * 8), a1 = *(const LAS f32x4*)(ys + tt * 512 + lane * 8 + 4);
                        const float mean = wave_sum((a0[0] + a0[1]) + (a0[2] + a0[3]) + (a1[0] + a1[1]) + (a1[2] + a1[3])) * (1.f / 512.f);
                        const f32x4 d0 = a0 - mean, d1 = a1 - mean;
                        const float var = wave_sum((d0[0] * d0[0] + d0[1] * d0[1]) + (d0[2] * d0[2] + d0[3] * d0[3]) + (d1[0] * d1[0] + d1[1] * d1[1]) + (d1[2] * d1[2] + d1[3] * d1[3])) * (1.f / 512.f);
                        const float rs = rsqrtf(var + EPS);
                        const f32x4 g0 = *(const f32x4*)(g_ln + lane * 8), g1 = *(const f32x4*)(g_ln + lane * 8 + 4), bb0 = *(const f32x4*)(b_ln + lane * 8), bb1 = *(const f32x4*)(b_ln + lane * 8 + 4);
                        f32x4 y0 = d0 * rs * g0 + bb0, y1 = d1 * rs * g1 + bb1;
#pragma unroll
                        for (int i = 0; i < 4; ++i) { y0[i] = y0[i] * sigmoidf_(y0[i]); y1[i] = y1[i] * sigmoidf_(y1[i]); }
                        u32x4 w; w.x = pk2(y0[0], y0[1]); w.y = pk2(y0[2], y0[3]); w.z = pk2(y1[0], y1[1]); w.w = pk2(y1[2], y1[3]);
                        *(u32x4*)(U + (size_t)(b * SEQ + t0 + tt) * 512 + lane * 8) = w;
                    }
                }
                __syncthreads();
            }
        }
        GRID_BAR();
        PHASE_BEGIN();

        if (PH(7)) {
            if (__builtin_amdgcn_readfirstlane(tid) >= 256) __builtin_amdgcn_s_setprio(1);
            if (G == 256) {
                const int grp = bid >> 6, bh = bid & 63;
#pragma unroll 1
                for (int rd = 0; rd < 4; ++rd) {
                    const int qb = (rd == 0) ? 15 - grp : (rd == 1) ? 8 + grp : (rd == 2) ? 7 - grp : grp;
                    __syncthreads();
                    mla_unit(ldc, bh >> 3, bh & 7, qb, Qa, Ka, Va, tid, lane, wave);
                }
            } else {
                for (int u = bid; u < 1024; u += G) { __syncthreads(); mla_unit(ldc, (u & 63) >> 3, u & 7, 15 - (u >> 6), Qa, Ka, Va, tid, lane, wave); }
            }
            __syncthreads();
            for (int i = 0; ; ++i) {
                const int L = i * G + bid; if (L >= 1024) break;
                const int rnd = L / 16, bg = L % 16;
                const int ri = rnd >> 4, rk = rnd & 15;
                const int qb = 63 - 16 * ri - ((ri & 1) ? 15 - rk : rk);
                nsa_unit(ldc, bg >> 1, bg & 1, qb, Z, KC, VC, On, tid, lane, wave);
            }
            __builtin_amdgcn_s_setprio(0);
        }
        GRID_BAR();
        PHASE_BEGIN();

        if (PH(8)) run_gemm(lds, Qa, 768, wt_omla, T, 1024, 768, FStoreBias{Z, ZP, 0, nullptr});
        if (PH(8)) run_gemm(lds, U, 512, wt_conv, T, 1024, 512, FStoreBias{Z, ZP, 1024, b_conv_out});
        if (PH(8)) run_gemm(lds, On, 512, wt_onsa, T, 1024, 512, FStoreBias{Z, ZP, 2048, nullptr});
        GRID_BAR();
        PHASE_BEGIN();

        run_gemm_triple(lds, HB, 1024, wt_g, T, ZP, 1024, EpiGate{Z, ZP, SS1});
        GRID_BAR();
        PHASE_BEGIN();

        for (int i = bid * NTHR + tid; i < T; i += G * NTHR) ((unsigned long long*)SS1)[i] = 0ull;
        run_gemm_epi(lds, Z, ZP, wt_out3, T, 1024, 1024, EpiResidStats{HB, H2, nullptr, SS2});
        GRID_BAR();
        PHASE_BEGIN();

        run_gemm(lds, H2, 1024, wt_ff1, T, 4096, 1024, FRelu2S{HDN, 4096, SS2});
        GRID_BAR();
        PHASE_BEGIN();

        run_gemm_epi(lds, HDN, 4096, wt_ff2, T, 1024, 4096, EpiResidStats{H2, HB, (layer == DEPTH - 1) ? xout : (float*)nullptr, SS1});
        GRID_BAR();
        PHASE_BEGIN();
    }
}

extern "C" void kernel_launch(void* const* d_in, const int* in_sizes, int n_in, void* d_out, int out_size, void* d_ws, size_t ws_size, hipStream_t stream) {
    static int grid = 0;
    if (grid == 0) {
        if (n_in != 30 || out_size != T * DM || ws_size < WS_END) { fprintf(stderr, "kernel_launch: unexpected shapes (n_in %d out %d ws %zu)\n", n_in, out_size, ws_size); grid = -1; return; }
        int dev = 0, cus = 0, per_cu = 0;
        hipGetDevice(&dev);
        hipDeviceGetAttribute(&cus, hipDeviceAttributeMultiprocessorCount, dev);
        hipFuncSetAttribute((const void*)hybrid_fwd, hipFuncAttributeMaxDynamicSharedMemorySize, LDS_BYTES);
        hipOccupancyMaxActiveBlocksPerMultiprocessor(&per_cu, (const void*)hybrid_fwd, NTHR, LDS_BYTES);
        if (per_cu < 1) per_cu = 1;
        grid = cus * per_cu;
        (void)hipGetLastError();
    }
    if (grid < 0) return;
    Args a{};
    for (int i = 0; i < 30; ++i) a.in[i] = (const float*)d_in[i];
    a.out = (float*)d_out; a.ws = (unsigned char*)d_ws;
    (void)hipMemsetAsync(d_ws, 0, 16384, stream);
    void* kargs[] = {&a};
    hipError_t e = hipLaunchCooperativeKernel((const void*)hybrid_fwd, dim3(grid), dim3(NTHR), kargs, LDS_BYTES, stream);
    if (e != hipSuccess) fprintf(stderr, "cooperative launch failed: %s (grid %d)\n", hipGetErrorString(e), grid);
}
```
